# Optimizing an MI355X kernel written in HIP

```python
import jax, jax.numpy as jnp
from jax import lax
import numpy as np


D_MODEL = 1024
BATCH = 2
SEQ = 16384
DEPTH = 4

HEAD_DIM = 32
SB_HEADS = 4
NSA_HEADS = 4
MOBA_HEADS = 4
Q_BLOCK = 128
SB_KTILE = 64
NSA_CMP_LEN = 32
NSA_CMP_STRIDE = 16
NSA_SEL_LEN = 64
NSA_TOP_N = 8
NSA_WINDOW = 512
MOBA_BLOCK = 256
MOBA_TOPK = 3
PEER_HEADS = 4
PEER_NKEYS = 128
PEER_N_EXPERTS = PEER_NKEYS * PEER_NKEYS
PEER_TOPK = 8
PEER_QDIM = 256
TOK_BLOCK = 128

N_BRANCHES = 3
SB_W = SB_HEADS * HEAD_DIM
NSA_W = NSA_HEADS * HEAD_DIM
MOBA_W = MOBA_HEADS * HEAD_DIM
IN_WIDTHS = (SB_W, SB_W, SB_W, NSA_W, HEAD_DIM, HEAD_DIM, HEAD_DIM, HEAD_DIM, HEAD_DIM, HEAD_DIM, 3 * NSA_HEADS, MOBA_W, HEAD_DIM, HEAD_DIM, N_BRANCHES * D_MODEL)
IN_WIDTH = sum(IN_WIDTHS)
DEEPNORM_ALPHA = (2.0 * DEPTH) ** 0.25
DEEPNORM_BETA = (8.0 * DEPTH) ** -0.25
LN_EPS = 1e-5

kernel_name = 'hybrid_sb_nsa_moba_peer_deepnorm'


def layer_norm(x, g, b):
    xf = x.astype(jnp.float32)
    mu = jnp.mean(xf, axis=-1, keepdims=True)
    var = jnp.mean(jnp.square(xf - mu), axis=-1, keepdims=True)
    return ((xf - mu) * lax.rsqrt(var + LN_EPS) * g + b).astype(x.dtype)


def masked_softmax(z, mask):
    z = jnp.where(mask, z.astype(jnp.float32), -jnp.inf)
    m = jnp.max(z, axis=-1, keepdims=True)
    m = jnp.where(jnp.isfinite(m), m, 0.0)
    p = jnp.exp(z - m)
    return p / jnp.maximum(jnp.sum(p, axis=-1, keepdims=True), 1e-30)


def alibi_slopes(n):
    return jnp.asarray([2.0 ** (-8.0 * (i + 1) / n) for i in range(n)], jnp.float32)


def stick_breaking_attention(q, k, v):
    B, H, S, dh = q.shape
    q = q * (dh ** -0.5)
    nkt = S // SB_KTILE
    kt = k.reshape(B, H, nkt, SB_KTILE, dh)
    vt = v.reshape(B, H, nkt, SB_KTILE, dh)
    tri = jnp.asarray(np.tril(np.ones((SB_KTILE, SB_KTILE), np.float32), k=-1))
    outs = []
    for i in range(S // Q_BLOCK):
        q0 = i * Q_BLOCK
        n = (q0 + Q_BLOCK) // SB_KTILE
        qb = q[:, :, q0:q0 + Q_BLOCK]
        z = jnp.einsum('bhqd,bhnkd->bhqnk', qb, kt[:, :, :n]).astype(jnp.float32)
        kpos = jnp.arange(n * SB_KTILE).reshape(n, SB_KTILE)
        qpos = q0 + jnp.arange(Q_BLOCK)
        past = kpos[None] < qpos[:, None, None]
        ls = jnp.where(past, -jax.nn.softplus(z), 0.0)
        tot = jnp.sum(ls, axis=-1)
        carry = lax.cumsum(tot, axis=3, reverse=True) - tot
        excl = jnp.einsum('bhqnj,js->bhqns', ls, tri) + carry[..., None]
        w = jnp.where(past, jnp.exp(z + ls + excl), 0.0)
        outs.append(jnp.einsum('bhqnk,bhnkd->bqhd', w.astype(v.dtype), vt[:, :, :n]))
    return jnp.concatenate(outs, axis=1).reshape(B, S, H * dh)


def nsa_attention(q, k_cmp, v_cmp, k_slc, v_slc, k_win, v_win, gates, pe_k, pe_v, w_ck, w_cv, slopes):
    B, S, H, dh = q.shape
    scale = dh ** -0.5
    nchunk = S // NSA_CMP_STRIDE
    nc = nchunk - 1

    def compress(t, pe, w):
        c = t.reshape(B, nchunk, NSA_CMP_STRIDE, dh)
        blocks = jnp.concatenate([c[:, :-1], c[:, 1:]], axis=2) + pe
        return jnp.einsum('bnf,fd->bnd', blocks.reshape(B, nc, NSA_CMP_LEN * dh), w)

    kc = compress(k_cmp, pe_k, w_ck)
    vc = compress(v_cmp, pe_v, w_cv)
    cend = jnp.arange(nc) * NSA_CMP_STRIDE + (NSA_CMP_LEN - 1)
    nsel = S // NSA_SEL_LEN
    top_n = min(NSA_TOP_N, nsel)
    ratio = NSA_SEL_LEN // NSA_CMP_STRIDE
    overlap = np.convolve(np.ones(ratio), np.ones(NSA_CMP_LEN // NSA_CMP_STRIDE)).tolist()
    n_left = (NSA_CMP_LEN - NSA_CMP_STRIDE) // NSA_CMP_STRIDE
    n_right = len(overlap) + ratio * (nsel - 1) - nc - n_left
    ks_blk = k_slc.reshape(B, nsel, NSA_SEL_LEN, dh)
    vs_blk = v_slc.reshape(B, nsel, NSA_SEL_LEN, dh)
    kw_pad = jnp.pad(k_win, ((0, 0), (NSA_WINDOW, 0), (0, 0)))
    vw_pad = jnp.pad(v_win, ((0, 0), (NSA_WINDOW, 0), (0, 0)))
    blk = jnp.arange(nsel)
    bidx = jnp.arange(B)[:, None, None]
    lpos = jnp.arange(NSA_SEL_LEN)
    nkeys_sel = top_n * NSA_SEL_LEN

    def block(i):
        q0 = i * Q_BLOCK
        qb = lax.dynamic_slice_in_dim(q, q0, Q_BLOCK, axis=1)
        qpos = q0 + jnp.arange(Q_BLOCK)
        dc = qpos[:, None] - cend[None, :]
        zc = jnp.einsum('bqhd,bnd->bhqn', qb, kc).astype(jnp.float32) * scale - slopes[:, None, None] * dc
        pc = masked_softmax(zc, dc >= 0)
        o_cmp = jnp.einsum('bhqn,bnd->bqhd', pc.astype(vc.dtype), vc)
        pg = jnp.pad(jnp.sum(pc, axis=1), ((0, 0), (0, 0), (n_left, n_right)))
        imp = sum(c * pg[..., o:o + ratio * nsel:ratio] for o, c in enumerate(overlap))
        cur = qpos // NSA_SEL_LEN
        forced = (blk[None, :] == 0) | (blk[None, :] == cur[:, None]) | (blk[None, :] == cur[:, None] - 1)
        future = blk[None, :] > cur[:, None]
        imp = jnp.where(future, -jnp.inf, jnp.where(forced, jnp.inf, imp))
        _, sel = lax.top_k(imp, top_n)
        ksel = ks_blk[bidx, sel]
        vsel = vs_blk[bidx, sel]
        spos = sel[..., None] * NSA_SEL_LEN + lpos
        ds = qpos[None, None, :, None, None] - spos[:, None]
        zs = jnp.einsum('bqhd,bqnld->bhqnl', qb, ksel).astype(jnp.float32) * scale - slopes[:, None, None, None] * ds
        ps = masked_softmax(zs.reshape(B, H, Q_BLOCK, nkeys_sel), (ds >= 0).reshape(B, 1, Q_BLOCK, nkeys_sel))
        o_slc = jnp.einsum('bhqnl,bqnld->bqhd', ps.reshape(B, H, Q_BLOCK, top_n, NSA_SEL_LEN).astype(vsel.dtype), vsel)
        kw = lax.dynamic_slice_in_dim(kw_pad, q0, Q_BLOCK + NSA_WINDOW, axis=1)
        vw = lax.dynamic_slice_in_dim(vw_pad, q0, Q_BLOCK + NSA_WINDOW, axis=1)
        wpos = q0 - NSA_WINDOW + jnp.arange(Q_BLOCK + NSA_WINDOW)
        dw = qpos[:, None] - wpos[None, :]
        mw = (dw >= 0) & (dw < NSA_WINDOW) & (wpos[None, :] >= 0)
        zw = jnp.einsum('bqhd,bkd->bhqk', qb, kw).astype(jnp.float32) * scale - slopes[:, None, None] * dw
        o_win = jnp.einsum('bhqk,bkd->bqhd', masked_softmax(zw, mw).astype(vw.dtype), vw)
        g = lax.dynamic_slice_in_dim(gates, q0, Q_BLOCK, axis=1)
        return g[..., 0:1] * o_cmp + g[..., 1:2] * o_slc + g[..., 2:3] * o_win

    out = lax.map(block, jnp.arange(S // Q_BLOCK))
    return jnp.swapaxes(out, 0, 1).reshape(B, S, H * dh)


def moba_attention(q, k, v, slopes):
    B, S, H, dh = q.shape
    scale = dh ** -0.5
    nb = -(-S // MOBA_BLOCK)
    pad = nb * MOBA_BLOCK - S
    kp = jnp.pad(k, ((0, 0), (0, pad), (0, 0)))
    vp = jnp.pad(v, ((0, 0), (0, pad), (0, 0)))
    k_blk = kp.reshape(B, nb, MOBA_BLOCK, dh)
    v_blk = vp.reshape(B, nb, MOBA_BLOCK, dh)
    k_mean = jnp.mean(k_blk, axis=2)
    top_k = min(MOBA_TOPK, nb)
    bidx = jnp.arange(B)[:, None, None]
    blk = jnp.arange(nb)
    lpos = jnp.arange(MOBA_BLOCK)
    nkeys_sel = top_k * MOBA_BLOCK

    def block(i):
        q0 = i * Q_BLOCK
        qb = lax.dynamic_slice_in_dim(q, q0, Q_BLOCK, axis=1)
        qpos = q0 + jnp.arange(Q_BLOCK)
        cur = q0 // MOBA_BLOCK
        sg = jnp.einsum('bqhd,bnd->bqn', qb, k_mean).astype(jnp.float32)
        sg = jnp.where(blk < cur, sg, -jnp.inf)
        gv, sel = lax.top_k(sg, top_k)
        ksel = k_blk[bidx, sel]
        vsel = v_blk[bidx, sel]
        spos = sel[..., None] * MOBA_BLOCK + lpos
        ds = qpos[None, None, :, None, None] - spos[:, None]
        zs = jnp.einsum('bqhd,bqnld->bhqnl', qb, ksel).astype(jnp.float32) * scale - slopes[:, None, None, None] * ds
        ms = jnp.broadcast_to(jnp.isfinite(gv)[:, None, :, :, None], zs.shape)
        ko = lax.dynamic_slice_in_dim(kp, cur * MOBA_BLOCK, MOBA_BLOCK, axis=1)
        vo = lax.dynamic_slice_in_dim(vp, cur * MOBA_BLOCK, MOBA_BLOCK, axis=1)
        do = qpos[:, None] - (cur * MOBA_BLOCK + lpos)[None, :]
        zo = jnp.einsum('bqhd,bld->bhql', qb, ko).astype(jnp.float32) * scale - slopes[:, None, None] * do
        mo = jnp.broadcast_to(do >= 0, zo.shape)
        z = jnp.concatenate([zs.reshape(B, H, Q_BLOCK, nkeys_sel), zo], axis=-1)
        m = jnp.concatenate([ms.reshape(B, H, Q_BLOCK, nkeys_sel), mo], axis=-1)
        p = masked_softmax(z, m).astype(v.dtype)
        ps = p[..., :nkeys_sel].reshape(B, H, Q_BLOCK, top_k, MOBA_BLOCK)
        po = p[..., nkeys_sel:]
        return jnp.einsum('bhqnl,bqnld->bqhd', ps, vsel) + jnp.einsum('bhql,bld->bqhd', po, vo)

    out = lax.map(block, jnp.arange(S // Q_BLOCK))
    return jnp.swapaxes(out, 0, 1).reshape(B, S, H * dh)


def peer_ffn(x, w_q, sub_k1, sub_k2, u_tab, v_tab):
    B, S, D = x.shape
    half = PEER_QDIM // 2
    xt = x.reshape(B * S // TOK_BLOCK, TOK_BLOCK, D)

    def block(xb):
        q = jnp.einsum('td,dhc->thc', xb, w_q)
        s1 = jnp.einsum('thc,hkc->thk', q[..., :half], sub_k1).astype(jnp.float32)
        s2 = jnp.einsum('thc,hkc->thk', q[..., half:], sub_k2).astype(jnp.float32)
        v1, i1 = lax.top_k(s1, PEER_TOPK)
        v2, i2 = lax.top_k(s2, PEER_TOPK)
        cand = (v1[..., :, None] + v2[..., None, :]).reshape(TOK_BLOCK, PEER_HEADS, PEER_TOPK * PEER_TOPK)
        cidx = (i1[..., :, None] * PEER_NKEYS + i2[..., None, :]).reshape(TOK_BLOCK, PEER_HEADS, PEER_TOPK * PEER_TOPK)
        top, pos = lax.top_k(cand, PEER_TOPK)
        idx = jnp.take_along_axis(cidx, pos, axis=-1)
        g = jax.nn.softmax(top, axis=-1)
        act = jax.nn.gelu(jnp.einsum('thkd,td->thk', u_tab[idx], xb).astype(jnp.float32))
        return jnp.einsum('thk,thkd->td', (g * act).astype(v_tab.dtype), v_tab[idx])

    return lax.map(block, xt).reshape(B, S, D)


def hybrid_layer(x, w_in, nsa_pe_k, nsa_pe_v, nsa_w_ck, nsa_w_cv, w_br_sb, w_br_nsa, w_br_moba, w_out, ln1_g, ln1_b, peer_wq, peer_k1, peer_k2, peer_u, peer_v, ln2_g, ln2_b, nsa_slopes, moba_slopes):
    B, S, D = x.shape
    split_points = np.cumsum(IN_WIDTHS)[:-1].tolist()
    (sb_q, sb_k, sb_v, nsa_q, ck, cv, sk, sv, wk, wv, nsa_g, mb_q, mb_k, mb_v, merge_g) = jnp.split(x @ w_in, split_points, axis=-1)
    heads = lambda t, h: t.reshape(B, S, h, HEAD_DIM)
    bhsd = lambda t, h: jnp.transpose(heads(t, h), (0, 2, 1, 3))
    o_sb = stick_breaking_attention(bhsd(sb_q, SB_HEADS), bhsd(sb_k, SB_HEADS), bhsd(sb_v, SB_HEADS))
    o_nsa = nsa_attention(heads(nsa_q, NSA_HEADS), ck, cv, sk, sv, wk, wv, jax.nn.sigmoid(nsa_g).reshape(B, S, NSA_HEADS, 3), nsa_pe_k, nsa_pe_v, nsa_w_ck, nsa_w_cv, nsa_slopes)
    o_moba = moba_attention(heads(mb_q, MOBA_HEADS), mb_k, mb_v, moba_slopes)
    g = jax.nn.sigmoid(merge_g).reshape(B, S, N_BRANCHES, D)
    mix = g[:, :, 0] * (o_sb @ w_br_sb) + g[:, :, 1] * (o_nsa @ w_br_nsa) + g[:, :, 2] * (o_moba @ w_br_moba)
    x = layer_norm(DEEPNORM_ALPHA * x + mix @ w_out, ln1_g, ln1_b)
    return layer_norm(DEEPNORM_ALPHA * x + peer_ffn(x, peer_wq, peer_k1, peer_k2, peer_u, peer_v), ln2_g, ln2_b)


def setup_inputs(seed: int = 0) -> dict:
    key = jax.random.key(seed)
    ks = jax.random.split(key, 20)
    L, D = DEPTH, D_MODEL
    nrm = lambda k, shape, s: s * jax.random.normal(k, shape, jnp.float32)
    return {
        'x': nrm(ks[0], (BATCH, SEQ, D), 1.0),
        'w_in': nrm(ks[1], (L, D, IN_WIDTH), D ** -0.5),
        'nsa_pe_k': nrm(ks[2], (L, NSA_CMP_LEN, HEAD_DIM), 0.02),
        'nsa_pe_v': nrm(ks[3], (L, NSA_CMP_LEN, HEAD_DIM), 0.02),
        'nsa_w_ck': nrm(ks[4], (L, NSA_CMP_LEN * HEAD_DIM, HEAD_DIM), (NSA_CMP_LEN * HEAD_DIM) ** -0.5),
        'nsa_w_cv': nrm(ks[5], (L, NSA_CMP_LEN * HEAD_DIM, HEAD_DIM), (NSA_CMP_LEN * HEAD_DIM) ** -0.5),
        'w_br_sb': nrm(ks[6], (L, SB_W, D), DEEPNORM_BETA * SB_W ** -0.5),
        'w_br_nsa': nrm(ks[7], (L, NSA_W, D), DEEPNORM_BETA * NSA_W ** -0.5),
        'w_br_moba': nrm(ks[8], (L, MOBA_W, D), DEEPNORM_BETA * MOBA_W ** -0.5),
        'w_out': nrm(ks[9], (L, D, D), DEEPNORM_BETA * D ** -0.5),
        'ln1_g': 1.0 + nrm(ks[10], (L, D), 0.01),
        'ln1_b': nrm(ks[11], (L, D), 0.01),
        'peer_wq': nrm(ks[12], (L, D, PEER_HEADS, PEER_QDIM), D ** -0.5),
        'peer_k1': nrm(ks[13], (L, PEER_HEADS, PEER_NKEYS, PEER_QDIM // 2), (PEER_QDIM // 2) ** -0.5),
        'peer_k2': nrm(ks[14], (L, PEER_HEADS, PEER_NKEYS, PEER_QDIM // 2), (PEER_QDIM // 2) ** -0.5),
        'peer_u': nrm(ks[15], (L, PEER_N_EXPERTS, D), D ** -0.5),
        'peer_v': nrm(ks[16], (L, PEER_N_EXPERTS, D), DEEPNORM_BETA * PEER_HEADS ** -0.5),
        'ln2_g': 1.0 + nrm(ks[17], (L, D), 0.01),
        'ln2_b': nrm(ks[18], (L, D), 0.01),
    }


def reference(x, w_in, nsa_pe_k, nsa_pe_v, nsa_w_ck, nsa_w_cv, w_br_sb, w_br_nsa, w_br_moba, w_out, ln1_g, ln1_b, peer_wq, peer_k1, peer_k2, peer_u, peer_v, ln2_g, ln2_b):
    slopes = alibi_slopes(NSA_HEADS + MOBA_HEADS)
    nsa_slopes = slopes[0::2]
    moba_slopes = slopes[1::2]
    for l in range(DEPTH):
        x = hybrid_layer(x, w_in[l], nsa_pe_k[l], nsa_pe_v[l], nsa_w_ck[l], nsa_w_cv[l], w_br_sb[l], w_br_nsa[l], w_br_moba[l], w_out[l], ln1_g[l], ln1_b[l], peer_wq[l], peer_k1[l], peer_k2[l], peer_u[l], peer_v[l], ln2_g[l], ln2_b[l], nsa_slopes, moba_slopes)
    return x
```

```cpp
#include <hip/hip_runtime.h>
#include <cstdio>
#include <cstdint>
#include <cmath>
namespace pg8 {
#define PG8_LAS __attribute__((address_space(3)))
typedef unsigned short bf16_t;
typedef short bf16x8 __attribute__((ext_vector_type(8)));
typedef float f32x4 __attribute__((ext_vector_type(4)));
typedef unsigned u32x4 __attribute__((ext_vector_type(4)));
constexpr int BM = 256, BK = 64, HALF = 128, HTB = HALF * BK * 2  , STAGE_BYTES = 8 * HTB, NXCD = 8, WGM = 8;

__host__ __device__ __forceinline__ int lds_byte(int r, int c) { const int st = (r >> 4) * 2 + (c >> 5), rr = r & 15, cc = c & 31, ob = rr * 64 + cc * 2; return st * 1024 + (ob ^ (((ob >> 9) & 1) << 5)); }
__host__ __device__ __forceinline__ void stage_rc(int b, int& R, int& C) { const int st = b / 1024, sb = b % 1024, swz = sb ^ (((sb >> 9) & 1) << 5); R = (st >> 1) * 16 + swz / 64; C = (st & 1) * 32 + (swz % 64) / 2; }
__host__ __device__ __forceinline__ int perm32(int rho) { const int n = rho >> 4, i = rho & 15; return 8 * (i >> 2) + 4 * n + (i & 3); }

struct Unit { int pm, pn; };
struct Gemm { const bf16_t* A; const bf16_t* Bt; int M, N, K; };

struct StaticOrder {
    int nM, nN, nwg, G, c;
    __host__ __device__ void init(int M, int N, int G_, int c_) { nM = M / BM; nN = N / BM; nwg = nM * nN; G = G_; c = c_; }
    __host__ __device__ bool next(int i, Unit& u) const {
        const long L = (long)i * G + c; if (L >= nwg) return false;
        int wgid = (int)L; { const int q = nwg / NXCD, r = nwg % NXCD, xcd = wgid % NXCD, off = wgid / NXCD; wgid = (xcd < r ? xcd * (q + 1) : r * (q + 1) + (xcd - r) * q) + off; }
        const int nig = WGM * nN, gid = wgid / nig, fm = gid * WGM, gsz = (nM - fm) < WGM ? (nM - fm) : WGM;
        u.pm = fm + ((wgid % nig) % gsz); u.pn = (wgid % nig) / gsz; return true;
    }
    __device__ __forceinline__ void a_ready(const Unit&) const {}
    __device__ __forceinline__ void done(const Unit&) const {}
};

__device__ __forceinline__ unsigned cvt_pk_bf16(float lo, float hi) { unsigned r; asm volatile("v_cvt_pk_bf16_f32 %0, %1, %2" : "=v"(r) : "v"(lo), "v"(hi)); return r; }
typedef float f32x2 __attribute__((ext_vector_type(2)));
__device__ __forceinline__ f32x2 gelu_pk(f32x2 v) {
    const f32x2 av = __builtin_elementwise_abs(v), d = av * 0.2316418882f + 1.0f;
    f32x2 t; t.x = __builtin_amdgcn_rcpf(d.x); t.y = __builtin_amdgcn_rcpf(d.y);
    f32x2 q = t * 0.5307027145f + (-0.7265760135f); q = q * t + 0.7107068705f; q = q * t + (-0.142248368f); q = q * t + 0.127414796f; q = q * t;
    const f32x2 s = (v * v) * (-0.72134752044f);
    f32x2 e; e.x = __builtin_amdgcn_exp2f(s.x); e.y = __builtin_amdgcn_exp2f(s.y);
    const f32x2 m = v * (q * e), r = v - m;
    f32x2 o; o.x = v.x < 0.f ? m.x : r.x; o.y = v.y < 0.f ? m.y : r.y; return o;
}

template <int ACT  > struct EpiBf16 {
    static constexpr bool PERM = true, AFTER_DRAIN = false; static_assert(ACT == 0 || ACT == 1, "EpiBf16: ACT is 0 (none) or 1 (gelu_pk)");
    bf16_t* O; int ldc; const float* bias; int split_cols; size_t split_stride; float scale0;
    __device__ __forceinline__ void operator()(const f32x4 (&acc)[2][2][4][2], const Unit& u, int wr, int wc, int fr, int fq) const {
        const int row0 = u.pm * BM + wr * 64 + fr; int colt = u.pn * BM; bf16_t* base = O;
        float sc = 1.f; if (split_cols) { const int t = colt / split_cols; base += (size_t)t * split_stride; colt -= t * split_cols; if (t == 0) sc = scale0; }
        const int col0 = colt + wc * 32 + 8 * fq, bcol0 = u.pn * BM + wc * 32 + 8 * fq;
        f32x4 bv[2][2];
#pragma unroll
        for (int bj = 0; bj < 2; ++bj)
#pragma unroll
            for (int n = 0; n < 2; ++n) bv[bj][n] = bias ? *(const f32x4*)(bias + bcol0 + bj * HALF + 4 * n) : (f32x4){0.f, 0.f, 0.f, 0.f};
#pragma unroll
        for (int ai = 0; ai < 2; ++ai)
#pragma unroll
            for (int m = 0; m < 4; ++m) { bf16_t* rowp = base + (size_t)(row0 + ai * HALF + m * 16) * ldc + col0;
#pragma unroll
                for (int bj = 0; bj < 2; ++bj) { f32x4 v0 = acc[ai][bj][m][0] + bv[bj][0], v1 = acc[ai][bj][m][1] + bv[bj][1];
                    if (ACT == 1) { f32x2 a = gelu_pk((f32x2){v0[0], v0[1]}), b = gelu_pk((f32x2){v0[2], v0[3]}), c = gelu_pk((f32x2){v1[0], v1[1]}), d = gelu_pk((f32x2){v1[2], v1[3]});
                        v0 = (f32x4){a.x, a.y, b.x, b.y}; v1 = (f32x4){c.x, c.y, d.x, d.y}; }
                    v0 = v0 * sc; v1 = v1 * sc; u32x4 w; w.x = cvt_pk_bf16(v0[0], v0[1]); w.y = cvt_pk_bf16(v0[2], v0[3]); w.z = cvt_pk_bf16(v1[0], v1[1]); w.w = cvt_pk_bf16(v1[2], v1[3]);
                    *(u32x4*)(rowp + bj * HALF) = w; } }
    }
};
template <class Epi, class Sched, bool ALIGN_EPI = false, bool SP2 = false>
__device__ __forceinline__ void gemm_phase(PG8_LAS unsigned char* lds, const Gemm g, const Sched& S, const Epi& E, const int wid) {
    int lane_o; asm volatile("v_mbcnt_lo_u32_b32 %0, -1, 0\n\tv_mbcnt_hi_u32_b32 %0, -1, %0" : "=v"(lane_o));
    const int lane = lane_o, tid = wid * 64 + lane, wr = wid >> 2, wc = wid & 3, fr = lane & 15, fq = lane >> 4;
    const int K = g.K, nt = K / BK;
    unsigned voffA[2], voffB[2];
#pragma unroll
    for (int i = 0; i < 2; ++i) { int R, C; stage_rc(tid * 16 + i * 8192, R, C); const int Rb = Epi::PERM ? ((R & ~31) + perm32(R & 31)) : R;
        voffA[i] = (unsigned)(R * K + C) * 2u; voffB[i] = (unsigned)(Rb * K + C) * 2u; }
    const size_t kstep = (size_t)(BK * 2);
    const size_t hstep = (size_t)HALF * K * 2;
    const size_t tstep = 2 * hstep;
    const unsigned ldsw = (unsigned)wid * 1024u;
    const int aoff = lds_byte(wr * 64 + fr, fq * 8), boff = lds_byte(wc * 32 + fr, fq * 8);
#define PG8_SA(b, h) (((b) * 2 + (h)) * HTB)
#define PG8_SB(b, h) ((4 + (b) * 2 + (h)) * HTB)
#define PG8_STAGE(bufoff, gbase, voff) do { _Pragma("unroll") for (int _i = 0; _i < 2; ++_i) \
        __builtin_amdgcn_global_load_lds((const unsigned*)((const char*)(gbase) + (voff)[_i]), (PG8_LAS unsigned*)(lds + (bufoff) + ldsw + _i * 8192), 16, 0, 0); } while (0)
#define PG8_LDA(dst, b, h) do { _Pragma("unroll") for (int m = 0; m < 4; ++m) _Pragma("unroll") for (int k = 0; k < 2; ++k) dst[m][k] = *(const PG8_LAS bf16x8*)(lds + PG8_SA(b, h) + aoff + m * 2048 + k * 1024); } while (0)
#define PG8_LDB(dst, b, h) do { _Pragma("unroll") for (int n = 0; n < 2; ++n) _Pragma("unroll") for (int k = 0; k < 2; ++k) dst[n][k] = *(const PG8_LAS bf16x8*)(lds + PG8_SB(b, h) + boff + n * 2048 + k * 1024); } while (0)
#define PG8_MMA(ai, bj, At, Bt) do { __builtin_amdgcn_s_setprio(1); _Pragma("unroll") for (int m = 0; m < 4; ++m) _Pragma("unroll") for (int n = 0; n < 2; ++n) _Pragma("unroll") for (int k = 0; k < 2; ++k) \
        acc[ai][bj][m][n] = __builtin_amdgcn_mfma_f32_16x16x32_bf16(Bt[n][k], At[m][k], acc[ai][bj][m][n], 0, 0, 0); __builtin_amdgcn_s_setprio(0); } while (0)
#define PG8_WAIT_V(n) asm volatile("s_waitcnt vmcnt(" #n ")" ::: "memory")
#define PG8_WAIT_L(n) asm volatile("s_waitcnt lgkmcnt(" #n ")" ::: "memory")
#define PG8_BAR __builtin_amdgcn_s_barrier()
#define PG8_SCHED __builtin_amdgcn_sched_barrier(0)
    Unit cur, nxt; int ui = 0;
    if (!S.next(0, cur)) return;
    f32x4 acc[2][2][4][2];
#pragma unroll
    for (int a = 0; a < 2; ++a)
#pragma unroll
        for (int b = 0; b < 2; ++b)
#pragma unroll
            for (int m = 0; m < 4; ++m)
#pragma unroll
                for (int n = 0; n < 2; ++n) acc[a][b][m][n] = (f32x4){0.f, 0.f, 0.f, 0.f};
    bf16x8 At[4][2], B0[2][2], B1[2][2];
    const char* cA = (const char*)g.A + (size_t)cur.pm * tstep; const char* cB = (const char*)g.Bt + (size_t)cur.pn * tstep;
    S.a_ready(cur);
    if constexpr (SP2) {
        PG8_STAGE(PG8_SB(0, 0), cB, voffB); PG8_STAGE(PG8_SB(0, 1), cB + hstep, voffB); PG8_STAGE(PG8_SA(0, 0), cA, voffA); PG8_STAGE(PG8_SA(0, 1), cA + hstep, voffA);
        if (wr == 1) PG8_BAR;
        PG8_WAIT_V(2); PG8_BAR;
        PG8_STAGE(PG8_SB(1, 0), cB + kstep, voffB); PG8_STAGE(PG8_SA(1, 0), cA + kstep, voffA); PG8_STAGE(PG8_SB(1, 1), cB + hstep + kstep, voffB);
        PG8_WAIT_V(6); PG8_BAR;
    } else {
        PG8_STAGE(PG8_SB(0, 0), cB, voffB); PG8_STAGE(PG8_SA(0, 0), cA, voffA); PG8_STAGE(PG8_SB(0, 1), cB + hstep, voffB); PG8_STAGE(PG8_SA(0, 1), cA + hstep, voffA);
        if (wr == 1) PG8_BAR;
        PG8_WAIT_V(4); PG8_BAR;
        PG8_STAGE(PG8_SB(1, 0), cB + kstep, voffB); PG8_STAGE(PG8_SA(1, 0), cA + kstep, voffA); PG8_STAGE(PG8_SB(1, 1), cB + hstep + kstep, voffB);
        PG8_WAIT_V(6); PG8_BAR;
    }
    for (;;) {
        const bool has_next = S.next(ui + 1, nxt);
        const char* nA = has_next ? (const char*)g.A + (size_t)nxt.pm * tstep : cA; const char* nB = has_next ? (const char*)g.Bt + (size_t)nxt.pn * tstep : cB;
        for (int t = 0; t < nt; t += 2) {
            const bool last = (t == nt - 2);
            const char* a1 = cA + (size_t)(t + 1) * kstep;
            const char* a2 = last ? nA : cA + (size_t)(t + 2) * kstep; const char* b2 = last ? nB : cB + (size_t)(t + 2) * kstep;
            const char* a3 = a2 + kstep; const char* b3 = b2 + kstep;
            if (last && has_next) S.a_ready(nxt);
            if constexpr (SP2) {
            PG8_LDB(B0, 0, 0); PG8_LDB(B1, 0, 1); PG8_SCHED; PG8_LDA(At, 0, 0); PG8_STAGE(PG8_SA(1, 1), a1 + hstep, voffA);
            PG8_WAIT_V(8); PG8_WAIT_L(0); PG8_BAR; PG8_MMA(0, 0, At, B0); PG8_MMA(0, 1, At, B1); PG8_BAR; PG8_SCHED;
            PG8_LDA(At, 0, 1); PG8_STAGE(PG8_SB(0, 0), b2, voffB); PG8_STAGE(PG8_SB(0, 1), b2 + hstep, voffB); PG8_STAGE(PG8_SA(0, 0), a2, voffA);
            PG8_WAIT_V(8); PG8_WAIT_L(0); PG8_BAR; PG8_MMA(1, 0, At, B0); PG8_MMA(1, 1, At, B1); PG8_BAR; PG8_SCHED;
            PG8_LDB(B0, 1, 0); PG8_LDB(B1, 1, 1); PG8_SCHED; PG8_LDA(At, 1, 0); PG8_STAGE(PG8_SA(0, 1), a2 + hstep, voffA);
            PG8_WAIT_V(8); PG8_WAIT_L(0); PG8_BAR; PG8_MMA(0, 0, At, B0); PG8_MMA(0, 1, At, B1); PG8_BAR; PG8_SCHED;
            PG8_LDA(At, 1, 1); PG8_STAGE(PG8_SB(1, 0), b3, voffB); PG8_STAGE(PG8_SB(1, 1), b3 + hstep, voffB); PG8_STAGE(PG8_SA(1, 0), a3, voffA);
            PG8_WAIT_V(8); PG8_WAIT_L(0); PG8_BAR; PG8_MMA(1, 0, At, B0); PG8_MMA(1, 1, At, B1); PG8_BAR; PG8_SCHED;
            } else {
            PG8_LDB(B0, 0, 0); PG8_SCHED; PG8_LDA(At, 0, 0); PG8_STAGE(PG8_SA(1, 1), a1 + hstep, voffA);
            PG8_WAIT_L(8); PG8_BAR; PG8_WAIT_L(0); PG8_MMA(0, 0, At, B0); PG8_BAR; PG8_SCHED;
            PG8_LDB(B1, 0, 1); PG8_STAGE(PG8_SB(0, 0), b2, voffB);
            PG8_BAR; PG8_WAIT_L(0); PG8_MMA(0, 1, At, B1); PG8_BAR;
            PG8_LDA(At, 0, 1); PG8_STAGE(PG8_SA(0, 0), a2, voffA);
            PG8_BAR; PG8_WAIT_L(0); PG8_MMA(1, 0, At, B0); PG8_BAR; PG8_SCHED;
            PG8_STAGE(PG8_SB(0, 1), b2 + hstep, voffB);
            PG8_WAIT_V(6); PG8_BAR; PG8_MMA(1, 1, At, B1); PG8_BAR;
            PG8_LDB(B0, 1, 0); PG8_SCHED; PG8_LDA(At, 1, 0); PG8_STAGE(PG8_SA(0, 1), a2 + hstep, voffA);
            PG8_WAIT_L(8); PG8_BAR; PG8_WAIT_L(0); PG8_MMA(0, 0, At, B0); PG8_BAR; PG8_SCHED;
            PG8_LDB(B1, 1, 1); PG8_STAGE(PG8_SB(1, 0), b3, voffB);
            PG8_BAR; PG8_WAIT_L(0); PG8_MMA(0, 1, At, B1); PG8_BAR;
            PG8_LDA(At, 1, 1); PG8_STAGE(PG8_SA(1, 0), a3, voffA);
            PG8_BAR; PG8_WAIT_L(0); PG8_MMA(1, 0, At, B0); PG8_BAR; PG8_SCHED;
            PG8_STAGE(PG8_SB(1, 1), b3 + hstep, voffB);
            PG8_WAIT_V(6); PG8_BAR; PG8_MMA(1, 1, At, B1); PG8_BAR;
            }
        }
        if constexpr (ALIGN_EPI) { if (wr == 0) PG8_BAR; }
        if constexpr (!Epi::AFTER_DRAIN) { E(acc, cur, wr, wc, fr, fq); S.done(cur); }
        if (!has_next) break;
#pragma unroll
        for (int a = 0; a < 2; ++a)
#pragma unroll
            for (int b = 0; b < 2; ++b)
#pragma unroll
                for (int m = 0; m < 4; ++m)
#pragma unroll
                    for (int n = 0; n < 2; ++n) acc[a][b][m][n] = (f32x4){0.f, 0.f, 0.f, 0.f};
        cur = nxt; cA = nA; cB = nB; ++ui;
        if constexpr (ALIGN_EPI) { if (wr == 1) PG8_BAR; }
    }
    PG8_WAIT_V(0);
    if constexpr (!ALIGN_EPI) { if (wr == 0) PG8_BAR; }
    PG8_BAR;
    if constexpr (Epi::AFTER_DRAIN) { E.fused(acc, cur, wr, wc, fr, fq, lds, wid, lane); S.done(cur); }
#undef PG8_SA
#undef PG8_SB
#undef PG8_STAGE
#undef PG8_LDA
#undef PG8_LDB
#undef PG8_MMA
#undef PG8_WAIT_V
#undef PG8_WAIT_L
#undef PG8_BAR
#undef PG8_SCHED
}
}

namespace pg8 {
typedef unsigned u32x4e __attribute__((ext_vector_type(4)));
__device__ __forceinline__ float bf_lo(unsigned w) { return __uint_as_float(w << 16); }
__device__ __forceinline__ float bf_hi(unsigned w) { return __uint_as_float(w & 0xffff0000u); }
__device__ __forceinline__ float sigmoidf_(float x) { return __builtin_amdgcn_rcpf(1.0f + __expf(-x)); }

struct BranchOrder {
    int G, c;
    __device__ bool next(int i, Unit& u) const {
        const int L = i * G + c; if (L >= 1536) return false;
        const int b = L >> 9, r = L & 511; u.pm = b * 128 + (r >> 2); u.pn = b * 4 + (r & 3); return true;
    }
    __device__ __forceinline__ void a_ready(const Unit&) const {}
    __device__ __forceinline__ void done(const Unit&) const {}
};
struct GateOrder {
    StaticOrder so;
    __device__ bool next(int i, Unit& u) const {
        Unit t; if (!so.next(i / 3, t)) return false;
        u.pm = t.pm; u.pn = (i % 3) * 4 + t.pn; return true;
    }
    __device__ __forceinline__ void a_ready(const Unit&) const {}
    __device__ __forceinline__ void done(const Unit&) const {}
};
struct EpiMerge {
    static constexpr bool PERM = true, AFTER_DRAIN = false;
    const bf16_t* P; bf16_t* MIX; int Mrows;
    __device__ __forceinline__ void operator()(const f32x4 (&acc)[2][2][4][2], const Unit& u, int wr, int wc, int fr, int fq) const {
        const int b = u.pn >> 2, pc = u.pn & 3;
        const int row0 = u.pm * BM + wr * 64 + fr, col0 = pc * BM + wc * 32 + 8 * fq;
        const bf16_t* Pb = P + (size_t)b * Mrows * 1024;
#pragma unroll
        for (int ai = 0; ai < 2; ++ai)
#pragma unroll
            for (int m = 0; m < 4; ++m) { const size_t ro = (size_t)(row0 + ai * HALF + m * 16) * 1024 + col0;
#pragma unroll
                for (int bj = 0; bj < 2; ++bj) {
                    const f32x4 v0 = acc[ai][bj][m][0], v1 = acc[ai][bj][m][1];
                    const u32x4 pw = *(const u32x4*)(Pb + ro + bj * HALF);
                    float r[8];
                    r[0] = sigmoidf_(v0[0]) * bf_lo(pw.x); r[1] = sigmoidf_(v0[1]) * bf_hi(pw.x); r[2] = sigmoidf_(v0[2]) * bf_lo(pw.y); r[3] = sigmoidf_(v0[3]) * bf_hi(pw.y);
                    r[4] = sigmoidf_(v1[0]) * bf_lo(pw.z); r[5] = sigmoidf_(v1[1]) * bf_hi(pw.z); r[6] = sigmoidf_(v1[2]) * bf_lo(pw.w); r[7] = sigmoidf_(v1[3]) * bf_hi(pw.w);
                    if (b > 0) { const u32x4 mw = *(const u32x4*)(MIX + ro + bj * HALF);
                        r[0] += bf_lo(mw.x); r[1] += bf_hi(mw.x); r[2] += bf_lo(mw.y); r[3] += bf_hi(mw.y); r[4] += bf_lo(mw.z); r[5] += bf_hi(mw.z); r[6] += bf_lo(mw.w); r[7] += bf_hi(mw.w); }
                    u32x4 w; w.x = cvt_pk_bf16(r[0], r[1]); w.y = cvt_pk_bf16(r[2], r[3]); w.z = cvt_pk_bf16(r[4], r[5]); w.w = cvt_pk_bf16(r[6], r[7]);
                    *(u32x4*)(MIX + ro + bj * HALF) = w; } }
    }
};
struct EpiBranch {
    static constexpr bool PERM = true, AFTER_DRAIN = false;
    bf16_t* O;
    __device__ __forceinline__ void operator()(const f32x4 (&acc)[2][2][4][2], const Unit& u, int wr, int wc, int fr, int fq) const {
        const int row0 = u.pm * BM + wr * 64 + fr, col0 = (u.pn & 3) * BM + wc * 32 + 8 * fq;
#pragma unroll
        for (int ai = 0; ai < 2; ++ai)
#pragma unroll
            for (int m = 0; m < 4; ++m) { bf16_t* rowp = O + (size_t)(row0 + ai * HALF + m * 16) * 1024 + col0;
#pragma unroll
                for (int bj = 0; bj < 2; ++bj) { const f32x4 v0 = acc[ai][bj][m][0], v1 = acc[ai][bj][m][1];
                    u32x4 w; w.x = cvt_pk_bf16(v0[0], v0[1]); w.y = cvt_pk_bf16(v0[2], v0[3]); w.z = cvt_pk_bf16(v1[0], v1[1]); w.w = cvt_pk_bf16(v1[2], v1[3]);
                    *(u32x4*)(rowp + bj * HALF) = w; } }
    }
};
struct EpiResF32 {
    static constexpr bool PERM = false, AFTER_DRAIN = false;
    const float* base; float* out; int ldc; float alpha;
    __device__ __forceinline__ void operator()(const f32x4 (&acc)[2][2][4][2], const Unit& u, int wr, int wc, int fr, int fq) const {
        const int col0 = u.pn * BM + wc * 32 + 4 * fq;
#pragma unroll
        for (int ai = 0; ai < 2; ++ai)
#pragma unroll
            for (int m = 0; m < 4; ++m) { const size_t off = (size_t)(u.pm * BM + ai * HALF + wr * 64 + m * 16 + fr) * ldc + col0;
#pragma unroll
                for (int bj = 0; bj < 2; ++bj)
#pragma unroll
                    for (int n = 0; n < 2; ++n) { const f32x4 bs = *(const f32x4*)(base + off + bj * HALF + n * 16); *(f32x4*)(out + off + bj * HALF + n * 16) = bs * alpha + acc[ai][bj][m][n]; } }
    }
};
}
#define GAS __attribute__((address_space(1)))
#define LAS __attribute__((address_space(3)))
#define XB_TMO      128
#define XB_XCNT(j)  (256  + 64 * (j))
#define XB_XSUB(j)  (1280 + 64 * (j))
#define XB_XGEN(j)  (2304 + 64 * (j))
#define XB_TOP      3328
#define XB_TOPGEN   3392
#define XCD_BAR_WORDS 3456
#define XB_SPIN_CAP (1u << 18)

__device__ __forceinline__ unsigned xb_ld(unsigned* p)              { return __hip_atomic_load(p, __ATOMIC_RELAXED, __HIP_MEMORY_SCOPE_AGENT); }
__device__ __forceinline__ unsigned xb_add(unsigned* p, unsigned v) { return __hip_atomic_fetch_add(p, v, __ATOMIC_RELAXED, __HIP_MEMORY_SCOPE_AGENT); }
__device__ __forceinline__ unsigned xb_xcc_id() { return (unsigned)__builtin_amdgcn_s_getreg((3 << 11) | 20) & 0xFu; }
#define XB_SPIN(cond, bar) do { unsigned _sp = 0; while (cond) { __builtin_amdgcn_s_sleep(1); \
    if ((++_sp & 255u) == 0u) { if (xb_ld(&(bar)[XB_TMO])) break; if (_sp > XB_SPIN_CAP) { atomicAdd(&(bar)[XB_TMO], 1u); break; } } } } while (0)

struct XcdBarrier {
    unsigned* bar; unsigned x;
    volatile LAS unsigned* st;
};

__device__ __forceinline__ XcdBarrier xcd_barrier_post(unsigned* bar, volatile LAS unsigned* st, bool leader) {
    XcdBarrier b; b.bar = bar; b.x = xb_xcc_id(); b.st = st;
    if (leader) (void)xb_add(&bar[XB_XCNT(b.x)], 1u);
    return b;
}
__device__ __forceinline__ void xcd_barrier_complete(unsigned* bar, unsigned x, unsigned& nloc, unsigned& nx) {
    const unsigned G = gridDim.x * gridDim.y * gridDim.z;
    unsigned sum, cnt, mine, sp = 0u;
    for (;;) {
        sum = 0u; cnt = 0u; mine = 0u;
#pragma unroll
        for (unsigned j = 0; j < 16; ++j) { const unsigned c = xb_ld(&bar[XB_XCNT(j)]); sum += c; cnt += (c > 0u) ? 1u : 0u; mine = (j == x) ? c : mine; }
        if (sum == G) break;
        __builtin_amdgcn_s_sleep(1);
        if ((++sp & 255u) == 0u) { if (xb_ld(&bar[XB_TMO])) break; if (sp > XB_SPIN_CAP) { atomicAdd(&bar[XB_TMO], 1u); break; } }
    }
    nloc = mine > 0u ? mine : 1u; nx = cnt > 0u ? cnt : 1u;
}

__device__ __forceinline__ void xcd_barrier(const XcdBarrier& b, bool leader) {
    asm volatile("s_waitcnt vmcnt(0)" ::: "memory");
    __syncthreads();
    if (leader) {
        unsigned* bar = b.bar; unsigned bx_ = b.x; asm volatile("" : "+s"(bar), "+s"(bx_));
        __builtin_amdgcn_s_waitcnt(0);
        unsigned nloc = b.st[0], nx = b.st[1];
        if (nloc == 0u) { xcd_barrier_complete(bar, bx_, nloc, nx); b.st[0] = nloc; b.st[1] = nx; }
        const unsigned old = xb_add(&bar[XB_XSUB(bx_)], 1u);
        const unsigned gen = old / nloc;
        if (old + 1u == (gen + 1u) * nloc) {
            __builtin_amdgcn_fence(__ATOMIC_RELEASE, "agent");
            asm volatile("s_waitcnt vmcnt(0)" ::: "memory");
            const unsigned og = xb_add(&bar[XB_TOP], 1u);
            const unsigned tg = og / nx;
            if (og + 1u == (tg + 1u) * nx) xb_add(&bar[XB_TOPGEN], 1u);
            else XB_SPIN(xb_ld(&bar[XB_TOPGEN]) == tg, bar);
            __builtin_amdgcn_fence(__ATOMIC_ACQUIRE, "agent");
            xb_add(&bar[XB_XGEN(bx_)], 1u);
            asm volatile("s_waitcnt vmcnt(0)" ::: "memory");
        } else {
            XB_SPIN(xb_ld(&bar[XB_XGEN(bx_)]) == gen, bar);
            __builtin_amdgcn_fence(__ATOMIC_ACQUIRE, "agent");
            asm volatile("s_waitcnt vmcnt(0)" ::: "memory");
        }
    }
    __syncthreads();
}

constexpr int NWAVES = 8;
constexpr int BATCH = 2, SEQ = 16384, D = 1024, DEPTH = 4, M = BATCH * SEQ, INW = 3980, NEXP = 16384;
constexpr float ALPHA = 1.681792830507429f, LN_EPS = 1e-5f, QK_SCALE = 0.17677669529663687f, LOG2E = 1.4426950408889634f;
constexpr float ZC = QK_SCALE * LOG2E;
constexpr int C_SBQ = 0, C_SBK = 128, C_SBV = 256, C_NQ = 384, C_CK = 512, C_CV = 544, C_SK = 576, C_SV = 608, C_WK = 640, C_WV = 672, C_MQ = 704, C_MK = 832, C_MV = 864, C_NG = 896;

constexpr size_t MiB = 1u << 20;
constexpr size_t WS_CTL = 0, CTL_ZERO_BYTES = 1 * MiB;
constexpr size_t WS_WQKV = 1 * MiB;
constexpr size_t WS_WGATE = 9 * MiB;
constexpr size_t WS_WBR = 33 * MiB;
constexpr size_t WS_WOUT = 36 * MiB;
constexpr size_t WS_WQ = 44 * MiB;
constexpr size_t WS_PK = 52 * MiB;
constexpr size_t WS_KC = 53 * MiB;
constexpr size_t WS_VC = WS_KC + 256 * 1024;
constexpr size_t WS_KMEAN = WS_VC + 256 * 1024;
constexpr size_t WS_UT = 54 * MiB;
constexpr size_t WS_VT = 182 * MiB;
constexpr size_t WS_X = 310 * MiB;
constexpr size_t WS_X1 = 438 * MiB;
constexpr size_t WS_XB = 566 * MiB;
constexpr size_t WS_QKV = 630 * MiB;
constexpr size_t WS_OCAT = 694 * MiB;
constexpr size_t WS_P = 718 * MiB;
constexpr size_t WS_Y = WS_P, WS_QP = WS_P + 128 * MiB;
constexpr size_t WS_END = 910 * MiB;
constexpr int CW_BAR = 4096;

constexpr int RING_OFF = 0, RING_BYTES = 131072;
constexpr int LDSCTL_OFF = RING_BYTES, MISC_OFF = LDSCTL_OFF + 320;
constexpr int LDS_BYTES = 147456;

typedef unsigned short bf16;
typedef unsigned v4u __attribute__((ext_vector_type(4)));
typedef float f32x4 __attribute__((ext_vector_type(4)));
typedef short bf16x8 __attribute__((ext_vector_type(8)));
#define LDS_WAIT() asm volatile("s_waitcnt lgkmcnt(0)" ::: "memory")

__device__ __forceinline__ unsigned f2bf(float f) { unsigned u = __builtin_bit_cast(unsigned, f); return (u + 0x7fffu + ((u >> 16) & 1u)) >> 16; }
__device__ __forceinline__ unsigned pk2(float lo, float hi) { return f2bf(lo) | (f2bf(hi) << 16); }
__device__ __forceinline__ float bflo(unsigned w) { return __uint_as_float(w << 16); }
__device__ __forceinline__ float bfhi(unsigned w) { return __uint_as_float(w & 0xffff0000u); }
__device__ __forceinline__ float bf1(bf16 h) { return __uint_as_float((unsigned)h << 16); }
__device__ __forceinline__ void unpack8(const v4u w, float* o) { o[0] = bflo(w.x); o[1] = bfhi(w.x); o[2] = bflo(w.y); o[3] = bfhi(w.y); o[4] = bflo(w.z); o[5] = bfhi(w.z); o[6] = bflo(w.w); o[7] = bfhi(w.w); }
__device__ __forceinline__ void load32bf(const bf16* p, float* o) {
    const v4u* q = (const v4u*)p; const v4u a = q[0], b = q[1], c = q[2], d = q[3];
    unpack8(a, o); unpack8(b, o + 8); unpack8(c, o + 16); unpack8(d, o + 24);
}
__device__ __forceinline__ void load32f(const float* p, float* o) {
    const f32x4* q = (const f32x4*)p;
#pragma unroll
    for (int i = 0; i < 8; ++i) { const f32x4 v = q[i]; o[4 * i] = v.x; o[4 * i + 1] = v.y; o[4 * i + 2] = v.z; o[4 * i + 3] = v.w; }
}
__device__ __forceinline__ void store32bf(bf16* p, const float* o) {
    v4u* q = (v4u*)p;
#pragma unroll
    for (int i = 0; i < 4; ++i) { v4u w; w.x = pk2(o[8 * i], o[8 * i + 1]); w.y = pk2(o[8 * i + 2], o[8 * i + 3]); w.z = pk2(o[8 * i + 4], o[8 * i + 5]); w.w = pk2(o[8 * i + 6], o[8 * i + 7]); q[i] = w; }
}
__device__ __forceinline__ float dot32(const float* a, const float* b) {
    float s0 = 0.f, s1 = 0.f, s2 = 0.f, s3 = 0.f;
#pragma unroll
    for (int i = 0; i < 32; i += 4) { s0 = fmaf(a[i], b[i], s0); s1 = fmaf(a[i + 1], b[i + 1], s1); s2 = fmaf(a[i + 2], b[i + 2], s2); s3 = fmaf(a[i + 3], b[i + 3], s3); }
    return (s0 + s1) + (s2 + s3);
}
__device__ __forceinline__ float ex2(float x) { return __builtin_amdgcn_exp2f(x); }
__device__ __forceinline__ float lg2(float x) { return __builtin_amdgcn_logf(x); }
__device__ __forceinline__ float shx(float v, int mask, int lane) { return __int_as_float(__builtin_amdgcn_ds_bpermute((lane ^ mask) << 2, __float_as_int(v))); }
__device__ __forceinline__ int shxi(int v, int mask, int lane) { return __builtin_amdgcn_ds_bpermute((lane ^ mask) << 2, v); }
__device__ __forceinline__ float wave_sum(float v, int lane) {
#pragma unroll
    for (int o = 1; o < 64; o <<= 1) v += shx(v, o, lane);
    return v;
}
__device__ __forceinline__ float quad_sum(float v, int lane) { v += shx(v, 1, lane); v += shx(v, 2, lane); return v; }
__device__ __forceinline__ int lane_id() { int l; asm volatile("v_mbcnt_lo_u32_b32 %0, -1, 0\n\tv_mbcnt_hi_u32_b32 %0, -1, %0" : "=v"(l)); return l; }
__device__ __forceinline__ int opq(int v) { asm volatile("" : "+s"(v)); return v; }
__device__ __forceinline__ unsigned char* opq_ptr(unsigned char* p) { asm volatile("" : "+s"(p)); return p; }
__device__ __forceinline__ int lane_zero() { int z; asm volatile("v_mov_b32 %0, 0" : "=v"(z)); return z; }

struct Ptrs {
    const float* in[19]; float* out; unsigned char* ws;
};

__device__ __forceinline__ void tr_item(const float* W, int pitch, int scol, int ncols, int K, int k0, bf16* WT, int drow0, LAS float* scr, int lane) {
#pragma unroll 8
    for (int i = 0; i < 32; ++i) { const int kk = 2 * i + (lane >> 5), c = lane & 31; scr[kk * 33 + c] = (c < ncols) ? W[(size_t)(k0 + kk) * pitch + scol + c] : 0.f; }
    LDS_WAIT(); asm volatile("" ::: "memory");
    const int c8 = lane & 7;
#pragma unroll
    for (int j = 0; j < 4; ++j) { const int n = (lane >> 3) + 8 * j; const LAS float* s = scr + (8 * c8) * 33 + n;
        v4u o; o.x = pk2(s[0 * 33], s[1 * 33]); o.y = pk2(s[2 * 33], s[3 * 33]); o.z = pk2(s[4 * 33], s[5 * 33]); o.w = pk2(s[6 * 33], s[7 * 33]);
        *(v4u*)(WT + (size_t)(drow0 + n) * K + k0 + 8 * c8) = o; }
    LDS_WAIT(); asm volatile("" ::: "memory");
}
__device__ __forceinline__ void cvt8(const float* src, bf16* dst) {
    const f32x4 a = *(const f32x4*)src, b = *(const f32x4*)(src + 4);
    v4u w; w.x = pk2(a.x, a.y); w.y = pk2(a.z, a.w); w.z = pk2(b.x, b.y); w.w = pk2(b.z, b.w); *(v4u*)dst = w;
}
__device__ __forceinline__ void prologue(const Ptrs& A, LAS unsigned char* lds, int vcu, int NGW, int wave) {
    const int lane = lane_id(), gw = vcu * NWAVES + wave;
    LAS float* scr = (LAS float*)(lds + RING_OFF + wave * 16384);
    unsigned char* ws = opq_ptr(A.ws);
    constexpr int IT_QKV = 16 * 32, IT_GATE = 16 * 96, IT_BR = 2 * 32, IT_OUT = 16 * 32, IT_WQ = 16 * 32, IT_L = IT_QKV + IT_GATE + 3 * IT_BR + IT_OUT + IT_WQ;
    for (int it = gw; it < DEPTH * IT_L; it += NGW) {
        const int l = it / IT_L; int r = it % IT_L;
        if (r < IT_QKV) { const int kb = r >> 5, di = r & 31; int scol, nc;
            if (di < 22) { scol = 32 * di; nc = 32; } else if (di < 26) { scol = 716 + 32 * (di - 22); nc = 32; } else if (di == 26) { scol = 844; nc = 32; } else if (di == 27) { scol = 876; nc = 32; }
            else if (di == 28) { scol = 704; nc = 12; } else { scol = 0; nc = 0; }
            tr_item(A.in[1] + (size_t)l * D * INW, INW, scol, nc, D, kb * 64, (bf16*)(ws + WS_WQKV) + (size_t)l * 1024 * 1024, di * 32, scr, lane); continue; }
        r -= IT_QKV;
        if (r < IT_GATE) { const int kb = r / 96, ni = r % 96;
            tr_item(A.in[1] + (size_t)l * D * INW, INW, 908 + 32 * ni, 32, D, kb * 64, (bf16*)(ws + WS_WGATE) + (size_t)l * 3072 * 1024, ni * 32, scr, lane); continue; }
        r -= IT_GATE;
        if (r < 3 * IT_BR) { const int b = r / IT_BR, q = r % IT_BR, kb = q >> 5, ni = q & 31;
            tr_item(A.in[6 + b] + (size_t)l * 128 * D, D, 32 * ni, 32, 128, kb * 64, (bf16*)(ws + WS_WBR) + (size_t)(l * 3 + b) * 1024 * 128, ni * 32, scr, lane); continue; }
        r -= 3 * IT_BR;
        if (r < IT_OUT) { const int kb = r >> 5, ni = r & 31;
            tr_item(A.in[9] + (size_t)l * D * D, D, 32 * ni, 32, D, kb * 64, (bf16*)(ws + WS_WOUT) + (size_t)l * 1024 * 1024, ni * 32, scr, lane); continue; }
        r -= IT_OUT;
        { const int kb = r >> 5, ni = r & 31;
            tr_item(A.in[12] + (size_t)l * D * D, D, 32 * ni, 32, D, kb * 64, (bf16*)(ws + WS_WQ) + (size_t)l * 1024 * 1024, ni * 32, scr, lane); }
    }
    const size_t gt = (size_t)gw * 64 + lane, NT = (size_t)NGW * 64;
    { const size_t n8 = (size_t)DEPTH * NEXP * D / 8; bf16* ut = (bf16*)(ws + WS_UT); bf16* vt = (bf16*)(ws + WS_VT);
      for (size_t i = gt; i < n8; i += NT) { cvt8(A.in[15] + i * 8, ut + i * 8); cvt8(A.in[16] + i * 8, vt + i * 8); } }
    { const size_t n8 = (size_t)M * D / 8; bf16* xb = (bf16*)(ws + WS_XB);
      for (size_t i = gt; i < n8; i += NT) cvt8(A.in[0] + i * 8, xb + i * 8); }
    { const size_t n8 = (size_t)DEPTH * 4 * 128 * 128 / 8; bf16* pk = (bf16*)(ws + WS_PK);
      for (size_t i = gt; i < n8; i += NT) { const size_t e = i * 8, lh = e >> 14, rest = e & 16383;
          cvt8(A.in[13] + e, pk + (lh * 2 + 0) * 16384 + rest); cvt8(A.in[14] + e, pk + (lh * 2 + 1) * 16384 + rest); } }
}

__device__ __forceinline__ void prep_phase(const Ptrs& A, int l, int vcu, int NGW, int wave) {
    const int lane = lane_id(), gw = vcu * NWAVES + wave;
    unsigned char* ws = opq_ptr(A.ws); const bf16* QKV = (const bf16*)(ws + WS_QKV);
    const int d = lane & 31, hf = lane >> 5, lz = lane_zero();
    for (int it = gw; it < 4092 + 128; it += NGW) {
        if (it < 4092) {
            const int kv = it / 2046, rr = it % 2046, b = rr / 1023, n = rr % 1023;
            const float* pe = A.in[kv ? 3 : 2] + (size_t)l * 1024; const float* w = A.in[kv ? 5 : 4] + (size_t)l * 1024 * 32;
            float acc = 0.f;
            for (int jj = 0; jj < 16; ++jj) { const int j = hf * 16 + jj; float c[32];
                load32bf(QKV + (size_t)(b * SEQ + 16 * n + j) * 1024 + (kv ? C_CV : C_CK) + lz, c);
#pragma unroll
                for (int e = 0; e < 32; ++e) acc = fmaf(c[e] + pe[j * 32 + e], w[(size_t)(j * 32 + e) * 32 + d], acc); }
            acc += shx(acc, 32, lane);
            if (hf == 0) ((float*)(ws + (kv ? WS_VC : WS_KC)))[(size_t)(b * 1024 + n) * 32 + d] = acc;
        } else {
            const int r = it - 4092, b = r >> 6, blk = r & 63; float s = 0.f;
            const bf16* p = QKV + (size_t)(b * SEQ + blk * 256 + hf * 128) * 1024 + C_MK + d;
            for (int i = 0; i < 128; ++i) s += bf1(p[(size_t)i * 1024]);
            s += shx(s, 32, lane);
            if (hf == 0) ((float*)(ws + WS_KMEAN))[(size_t)(b * 64 + blk) * 32 + d] = s * (1.0f / 256.0f);
        }
    }
}

struct OnlineSm { float m, l; };
__device__ __forceinline__ void osm_step(OnlineSm& s, float* o, float z2, bool valid, const float* v) {
    const float mn = valid ? fmaxf(s.m, z2) : s.m;
    const float a = ex2(s.m - mn);
    const float al = (s.m == mn) ? 1.0f : a;
    const float p = valid ? ex2(z2 - mn) : 0.f;
    s.l = s.l * al + p; s.m = mn;
#pragma unroll
    for (int i = 0; i < 32; ++i) o[i] = fmaf(p, v[i], o[i] * al);
}

__device__ __forceinline__ void sb_item(unsigned char* ws, int item, int lane) {
    const bf16* QKV = (const bf16*)(ws + WS_QKV); bf16* OSB = (bf16*)(ws + WS_OCAT);
    const int b = item >> 10, h = (item >> 8) & 3, g = item & 255, t = g * 64 + lane, lz = lane_zero();
    float q[32], o[32];
    load32bf(QKV + (size_t)(b * SEQ + t) * 1024 + C_SBQ + h * 32, q);
#pragma unroll
    for (int i = 0; i < 32; ++i) o[i] = 0.f;
    float carry = 0.f;
    const bf16* kb = QKV + (size_t)b * SEQ * 1024 + C_SBK + h * 32 + lz; const bf16* vb = QKV + (size_t)b * SEQ * 1024 + C_SBV + h * 32 + lz;
    for (int s = g * 64 + 62; s >= 0; --s) {
        float k[32], v[32];
        load32bf(kb + (size_t)s * 1024, k); load32bf(vb + (size_t)s * 1024, v);
        const float z2 = dot32(q, k) * ZC;
        const float sp = fmaxf(z2, 0.f) + lg2(1.0f + ex2(-fabsf(z2)));
        const bool valid = s < t;
        const float w = valid ? ex2(z2 - sp + carry) : 0.f;
        carry -= valid ? sp : 0.f;
#pragma unroll
        for (int i = 0; i < 32; ++i) o[i] = fmaf(w, v[i], o[i]);
        if (__all(carry < -151.0f)) break;
    }
    store32bf(OSB + (size_t)(b * SEQ + t) * 128 + h * 32, o);
}

__device__ __forceinline__ void nsa_item(unsigned char* ws, int b, int tg, int lane) {
    const bf16* QKV = (const bf16*)(ws + WS_QKV); bf16* ONSA = (bf16*)(ws + WS_OCAT) + (size_t)M * 128;
    const float* KC = (const float*)(ws + WS_KC) + (size_t)b * 1024 * 32; const float* VC = (const float*)(ws + WS_VC) + (size_t)b * 1024 * 32;
    const int t0 = tg * 16, h = lane & 3, t = t0 + (lane >> 2), lz = lane_zero(), cur = t >> 6;
    const size_t row = (size_t)(b * SEQ + t) * 1024;
    const float slope2 = LOG2E * (h == 0 ? 0.5f : h == 1 ? 0.125f : h == 2 ? 0.03125f : 0.0078125f);
    float q[32], out[32];
    load32bf(QKV + row + C_NQ + h * 32, q);
    const float g0 = 1.0f / (1.0f + __expf(-bf1(QKV[row + C_NG + h * 3 + 0]))), g1 = 1.0f / (1.0f + __expf(-bf1(QKV[row + C_NG + h * 3 + 1]))), g2 = 1.0f / (1.0f + __expf(-bf1(QKV[row + C_NG + h * 3 + 2])));
    const int ncnt = (t0 + 15 >= 31) ? ((t0 + 15 - 31) >> 4) + 1 : 0;
    float m = -INFINITY, l = 0.f;
    for (int n = 0; n < ncnt; ++n) { float k[32]; load32f(KC + (size_t)n * 32 + lz, k);
        const int dc = t - (16 * n + 31); const float z2 = dot32(q, k) * ZC - slope2 * (float)dc;
        if (dc >= 0) { const float mn = fmaxf(m, z2); l = l * ((m == mn) ? 1.0f : ex2(m - mn)) + ex2(z2 - mn); m = mn; } }
    const float inv_l = (l > 0.f) ? 1.0f / l : 0.f;
    float tv[5], o[32]; int ti[5];
#pragma unroll
    for (int i = 0; i < 5; ++i) { tv[i] = -1.0f; ti[i] = -1; }
#pragma unroll
    for (int i = 0; i < 32; ++i) o[i] = 0.f;
    float Pprev = 0.f, acc = 0.f;
    for (int n = 0; n < ncnt; ++n) { float k[32], v[32]; load32f(KC + (size_t)n * 32 + lz, k); load32f(VC + (size_t)n * 32 + lz, v);
        const int dc = t - (16 * n + 31); const float z2 = dot32(q, k) * ZC - slope2 * (float)dc;
        const float p = (dc >= 0) ? ex2(z2 - m) * inv_l : 0.f;
#pragma unroll
        for (int i = 0; i < 32; ++i) o[i] = fmaf(p, v[i], o[i]);
        const float P = quad_sum(p, lane); const int r = n & 3, j = n >> 2;
        acc = (r == 0) ? (Pprev + 2.0f * P) : (r == 3 ? acc + P : acc + 2.0f * P);
        Pprev = P;
        if (r == 3) {
            const bool ins = (j >= 1) && (j <= cur - 2) && (acc > tv[4]);
            tv[4] = ins ? acc : tv[4]; ti[4] = ins ? j : ti[4];
#pragma unroll
            for (int kk = 4; kk >= 1; --kk) { const bool sw = tv[kk] > tv[kk - 1];
                const float fa = tv[kk], fb = tv[kk - 1]; const int ia = ti[kk], ib = ti[kk - 1];
                tv[kk - 1] = sw ? fa : fb; tv[kk] = sw ? fb : fa; ti[kk - 1] = sw ? ia : ib; ti[kk] = sw ? ib : ia; }
        }
    }
#pragma unroll
    for (int i = 0; i < 32; ++i) out[i] = g0 * o[i];
    {
        OnlineSm sm{-INFINITY, 0.f};
#pragma unroll
        for (int i = 0; i < 32; ++i) o[i] = 0.f;
        const bf16* kb = QKV + (size_t)b * SEQ * 1024 + C_SK; const bf16* vb = QKV + (size_t)b * SEQ * 1024 + C_SV;
        for (int slot = 0; slot < 8; ++slot) {
            const int blk = slot == 0 ? 0 : slot == 1 ? (cur >= 2 ? cur - 1 : -1) : slot == 2 ? (cur >= 1 ? cur : -1) : slot == 3 ? ti[0] : slot == 4 ? ti[1] : slot == 5 ? ti[2] : slot == 6 ? ti[3] : ti[4];
            if (__all(blk < 0)) continue;
            const int bb = blk < 0 ? 0 : blk;
            for (int kk = 0; kk < 64; ++kk) { const int pos = bb * 64 + kk; float k[32], v[32];
                load32bf(kb + (size_t)pos * 1024, k); load32bf(vb + (size_t)pos * 1024, v);
                const float z2 = dot32(q, k) * ZC - slope2 * (float)(t - pos);
                osm_step(sm, o, z2, blk >= 0 && pos <= t, v); }
        }
        const float il = 1.0f / sm.l;
#pragma unroll
        for (int i = 0; i < 32; ++i) out[i] = fmaf(g1 * il, o[i], out[i]);
    }
    {
        OnlineSm sm{-INFINITY, 0.f};
#pragma unroll
        for (int i = 0; i < 32; ++i) o[i] = 0.f;
        const bf16* kb = QKV + (size_t)b * SEQ * 1024 + C_WK + lz; const bf16* vb = QKV + (size_t)b * SEQ * 1024 + C_WV + lz;
        const int p0 = (t0 - 511 > 0) ? t0 - 511 : 0;
        for (int pos = p0; pos <= t0 + 15; ++pos) { float k[32], v[32];
            load32bf(kb + (size_t)pos * 1024, k); load32bf(vb + (size_t)pos * 1024, v);
            const int dw = t - pos; const float z2 = dot32(q, k) * ZC - slope2 * (float)dw;
            osm_step(sm, o, z2, dw >= 0 && dw < 512, v); }
        const float il = 1.0f / sm.l;
#pragma unroll
        for (int i = 0; i < 32; ++i) out[i] = fmaf(g2 * il, o[i], out[i]);
    }
    store32bf(ONSA + (size_t)(b * SEQ + t) * 128 + h * 32, out);
}

__device__ __forceinline__ void moba_item(unsigned char* ws, int b, int tg, int lane) {
    const bf16* QKV = (const bf16*)(ws + WS_QKV); bf16* OMB = (bf16*)(ws + WS_OCAT) + (size_t)2 * M * 128;
    const float* KM = (const float*)(ws + WS_KMEAN) + (size_t)b * 64 * 32;
    const int t0 = tg * 16, h = lane & 3, t = t0 + (lane >> 2), lz = lane_zero(), cur = t0 >> 8;
    const float slope2 = LOG2E * (h == 0 ? 0.25f : h == 1 ? 0.0625f : h == 2 ? 0.015625f : 0.00390625f);
    float q[32], o[32];
    load32bf(QKV + (size_t)(b * SEQ + t) * 1024 + C_MQ + h * 32, q);
    float tv[3]; int ti[3];
#pragma unroll
    for (int i = 0; i < 3; ++i) { tv[i] = -INFINITY; ti[i] = -1; }
    for (int n = 0; n < cur; ++n) { float k[32]; load32f(KM + (size_t)n * 32 + lz, k);
        const float sg = quad_sum(dot32(q, k), lane);
        const bool ins = sg > tv[2]; tv[2] = ins ? sg : tv[2]; ti[2] = ins ? n : ti[2];
#pragma unroll
        for (int kk = 2; kk >= 1; --kk) { const bool sw = tv[kk] > tv[kk - 1];
            const float fa = tv[kk], fb = tv[kk - 1]; const int ia = ti[kk], ib = ti[kk - 1];
            tv[kk - 1] = sw ? fa : fb; tv[kk] = sw ? fb : fa; ti[kk - 1] = sw ? ia : ib; ti[kk] = sw ? ib : ia; }
    }
    OnlineSm sm{-INFINITY, 0.f};
#pragma unroll
    for (int i = 0; i < 32; ++i) o[i] = 0.f;
    const bf16* kb = QKV + (size_t)b * SEQ * 1024 + C_MK; const bf16* vb = QKV + (size_t)b * SEQ * 1024 + C_MV;
    for (int slot = 0; slot < 3; ++slot) {
        const int blk = slot == 0 ? ti[0] : slot == 1 ? ti[1] : ti[2];
        if (__all(blk < 0)) continue;
        const int bb = blk < 0 ? 0 : blk;
        for (int kk = 0; kk < 256; ++kk) { const int pos = bb * 256 + kk; float k[32], v[32];
            load32bf(kb + (size_t)pos * 1024, k); load32bf(vb + (size_t)pos * 1024, v);
            const float z2 = dot32(q, k) * ZC - slope2 * (float)(t - pos);
            osm_step(sm, o, z2, blk >= 0, v); }
    }
    for (int pos = cur * 256; pos <= t0 + 15; ++pos) { float k[32], v[32];
        load32bf(kb + (size_t)pos * 1024 + lz, k); load32bf(vb + (size_t)pos * 1024 + lz, v);
        const float z2 = dot32(q, k) * ZC - slope2 * (float)(t - pos);
        osm_step(sm, o, z2, pos <= t, v); }
    const float il = 1.0f / sm.l;
#pragma unroll
    for (int i = 0; i < 32; ++i) o[i] *= il;
    store32bf(OMB + (size_t)(b * SEQ + t) * 128 + h * 32, o);
}

__device__ __forceinline__ void attn_phase_simple(unsigned char* ws_, int vcu, int wave) {
    unsigned char* ws = opq_ptr(ws_);
    const int lane = lane_id();
#ifndef NO_NSA
    { const int k = vcu * 4 + (wave & 3); if (wave < 4) nsa_item(ws, 0, k, lane); else nsa_item(ws, 1, 1023 - k, lane); }
#endif
#ifndef NO_MOBA
    { const int it = vcu * 8 + wave; moba_item(ws, it >> 10, it & 1023, lane); }
#endif
#ifndef NO_SB
    sb_item(ws, vcu * 8 + wave, lane);
#endif
}

__device__ __forceinline__ void ln_row(const float* y16, const float* g, const float* bta, int lane, float* o16) {
    float s = 0.f;
#pragma unroll
    for (int i = 0; i < 16; ++i) s += y16[i];
    const float mean = wave_sum(s, lane) * (1.0f / D); float s2 = 0.f;
#pragma unroll
    for (int i = 0; i < 16; ++i) { const float dd = y16[i] - mean; s2 = fmaf(dd, dd, s2); }
    const float rstd = 1.0f / sqrtf(wave_sum(s2, lane) * (1.0f / D) + LN_EPS);
#pragma unroll
    for (int hh = 0; hh < 2; ++hh)
#pragma unroll
        for (int i = 0; i < 8; ++i) { const int c = hh * 512 + lane * 8 + i; o16[hh * 8 + i] = (y16[hh * 8 + i] - mean) * rstd * g[c] + bta[c]; }
}
__device__ __forceinline__ void load_row16(const float* row, int lane, float* v) {
#pragma unroll
    for (int hh = 0; hh < 2; ++hh) { const f32x4 a = *(const f32x4*)(row + hh * 512 + lane * 8), b = *(const f32x4*)(row + hh * 512 + lane * 8 + 4);
        v[hh * 8 + 0] = a.x; v[hh * 8 + 1] = a.y; v[hh * 8 + 2] = a.z; v[hh * 8 + 3] = a.w; v[hh * 8 + 4] = b.x; v[hh * 8 + 5] = b.y; v[hh * 8 + 6] = b.z; v[hh * 8 + 7] = b.w; }
}
__device__ __forceinline__ void store_row16(float* row, bf16* rowb, int lane, const float* v) {
#pragma unroll
    for (int hh = 0; hh < 2; ++hh) {
        *(f32x4*)(row + hh * 512 + lane * 8) = (f32x4){v[hh * 8], v[hh * 8 + 1], v[hh * 8 + 2], v[hh * 8 + 3]};
        *(f32x4*)(row + hh * 512 + lane * 8 + 4) = (f32x4){v[hh * 8 + 4], v[hh * 8 + 5], v[hh * 8 + 6], v[hh * 8 + 7]};
        if (rowb) { v4u w; w.x = pk2(v[hh * 8], v[hh * 8 + 1]); w.y = pk2(v[hh * 8 + 2], v[hh * 8 + 3]); w.z = pk2(v[hh * 8 + 4], v[hh * 8 + 5]); w.w = pk2(v[hh * 8 + 6], v[hh * 8 + 7]);
            *(v4u*)(rowb + hh * 512 + lane * 8) = w; }
    }
}
__device__ __forceinline__ void ln1_phase(const Ptrs& A, int l, int vcu, int NGW, int wave) {
    const int lane = lane_id(), gw = vcu * NWAVES + wave;
    unsigned char* ws = opq_ptr(A.ws); const float* Y = (const float*)(ws + WS_Y); float* X1 = (float*)(ws + WS_X1); bf16* X1B = (bf16*)(ws + WS_XB);
    const float* g = A.in[10] + (size_t)l * D; const float* bt = A.in[11] + (size_t)l * D;
    for (int m = gw; m < M; m += NGW) { float y[16], o[16]; load_row16(Y + (size_t)m * D, lane, y); ln_row(y, g, bt, lane, o); store_row16(X1 + (size_t)m * D, X1B + (size_t)m * D, lane, o); }
}

__device__ __forceinline__ float gelu_tanh(float x) {
    const float u = 0.7978845608028654f * (x + 0.044715f * x * x * x);
    const float e = __expf(-2.0f * fabsf(u)); const float th = (1.0f - e) / (1.0f + e);
    return 0.5f * x * (1.0f + (u < 0.f ? -th : th));
}
__device__ __forceinline__ void peer_wave(const Ptrs& A, int l, int vcu, bool last, int wave) {
    const int lane = lane_id(), tok0 = (vcu * NWAVES + wave) * 16;
    unsigned char* ws = opq_ptr(A.ws);
    const bf16* QP = (const bf16*)(ws + WS_QP); const bf16* PK = (const bf16*)(ws + WS_PK) + (size_t)l * 4 * 2 * 16384;
    const bf16* UT = (const bf16*)(ws + WS_UT) + (size_t)l * NEXP * D; const bf16* VT = (const bf16*)(ws + WS_VT) + (size_t)l * NEXP * D;
    const float* X1 = (const float*)(ws + WS_X1);
    float* Xout = last ? A.out : (float*)(ws + WS_X); bf16* XBout = last ? nullptr : (bf16*)(ws + WS_XB);
    const int col = lane & 15, qd = lane >> 4;
    float mytop[8]; int myidx[8];
#pragma unroll
    for (int i = 0; i < 8; ++i) { mytop[i] = 0.f; myidx[i] = 0; }
#pragma unroll 1
    for (int h = 0; h < 4; ++h) {
        float v12[2][8]; int i12[2][8];
#pragma unroll
        for (int half = 0; half < 2; ++half) {
            f32x4 sc[8];
#pragma unroll
            for (int kt = 0; kt < 8; ++kt) sc[kt] = (f32x4){0.f, 0.f, 0.f, 0.f};
            const bf16* kp = PK + (size_t)(h * 2 + half) * 16384 + (size_t)col * 128 + qd * 8;
            const bf16* qp = QP + (size_t)(tok0 + col) * 1024 + h * 256 + half * 128 + qd * 8;
#pragma unroll
            for (int ks = 0; ks < 4; ++ks) { const bf16x8 bq = __builtin_bit_cast(bf16x8, *(const v4u*)(qp + ks * 32));
#pragma unroll
                for (int kt = 0; kt < 8; ++kt) { const bf16x8 ak = __builtin_bit_cast(bf16x8, *(const v4u*)(kp + (size_t)kt * 16 * 128 + ks * 32));
                    sc[kt] = __builtin_amdgcn_mfma_f32_16x16x32_bf16(ak, bq, sc[kt], 0, 0, 0); } }
#pragma unroll
            for (int r8 = 0; r8 < 8; ++r8) {
                float best = -INFINITY; int bi = 0x7fffffff;
#pragma unroll
                for (int kt = 0; kt < 8; ++kt)
#pragma unroll
                    for (int rr = 0; rr < 4; ++rr) { const float v = sc[kt][rr]; const bool tk = v > best; best = tk ? v : best; bi = tk ? (kt * 16 + 4 * qd + rr) : bi; }
#pragma unroll
                for (int off = 16; off <= 32; off <<= 1) { const float ov = shx(best, off, lane); const int oi = shxi(bi, off, lane);
                    const bool tk = (ov > best) || (ov == best && oi < bi); best = tk ? ov : best; bi = tk ? oi : bi; }
                v12[half][r8] = best; i12[half][r8] = bi;
#pragma unroll
                for (int kt = 0; kt < 8; ++kt)
#pragma unroll
                    for (int rr = 0; rr < 4; ++rr) sc[kt][rr] = ((kt * 16 + 4 * qd + rr) == bi) ? -INFINITY : sc[kt][rr];
            }
        }
        float cv[20]; int ce[20];
        {
            constexpr int A20[20] = {0, 0, 0, 0, 0, 0, 0, 0, 1, 1, 1, 1, 2, 2, 3, 3, 4, 5, 6, 7}, B20[20] = {0, 1, 2, 3, 4, 5, 6, 7, 0, 1, 2, 3, 0, 1, 0, 1, 0, 0, 0, 0};
#pragma unroll
            for (int e = 0; e < 20; ++e) { cv[e] = v12[0][A20[e]] + v12[1][B20[e]]; ce[e] = i12[0][A20[e]] * 128 + i12[1][B20[e]]; }
        }
#pragma unroll
        for (int r8 = 0; r8 < 8; ++r8) {
            float best = -INFINITY; int be = 0, bx = -1;
#pragma unroll
            for (int e = 0; e < 20; ++e) { const bool tk = cv[e] > best; best = tk ? cv[e] : best; be = tk ? ce[e] : be; bx = tk ? e : bx; }
#pragma unroll
            for (int e = 0; e < 20; ++e) cv[e] = (e == bx) ? -INFINITY : cv[e];
            if (qd == h) { mytop[r8] = best; myidx[r8] = be; }
        }
    }
    float myg[8];
    { float s = 0.f;
#pragma unroll
      for (int i = 0; i < 8; ++i) { myg[i] = __expf(mytop[i] - mytop[0]); s += myg[i]; }
      const float is = 1.0f / s;
#pragma unroll
      for (int i = 0; i < 8; ++i) myg[i] *= is; }
    const float* g2 = A.in[17] + (size_t)l * D; const float* b2 = A.in[18] + (size_t)l * D;
#pragma unroll 1
    for (int tt = 0; tt < 16; ++tt) {
        const int tok = tok0 + tt;
        float xr[16], outv[16];
        load_row16(X1 + (size_t)tok * D, lane, xr);
#pragma unroll
        for (int i = 0; i < 16; ++i) outv[i] = 0.f;
#pragma unroll 1
        for (int h = 0; h < 4; ++h) {
            const int src = tt + 16 * h; float dp[8]; int ex[8];
#pragma unroll
            for (int e = 0; e < 8; ++e) {
                ex[e] = __builtin_amdgcn_readlane(myidx[e], src);
                const bf16* ur = UT + (size_t)ex[e] * D;
                const v4u a = *(const v4u*)(ur + lane * 8), c = *(const v4u*)(ur + 512 + lane * 8);
                float f[16]; unpack8(a, f); unpack8(c, f + 8);
                float s = 0.f;
#pragma unroll
                for (int i = 0; i < 16; ++i) s = fmaf(f[i], xr[i], s);
                dp[e] = s;
            }
#pragma unroll
            for (int e = 0; e < 8; ++e) dp[e] = wave_sum(dp[e], lane);
#pragma unroll
            for (int e = 0; e < 8; ++e) {
                const float gg = __int_as_float(__builtin_amdgcn_readlane(__float_as_int(myg[e]), src));
                const float w = gg * gelu_tanh(dp[e]);
                const bf16* vr = VT + (size_t)ex[e] * D;
                const v4u a = *(const v4u*)(vr + lane * 8), c = *(const v4u*)(vr + 512 + lane * 8);
                float f[16]; unpack8(a, f); unpack8(c, f + 8);
#pragma unroll
                for (int i = 0; i < 16; ++i) outv[i] = fmaf(w, f[i], outv[i]);
            }
        }
        float y[16], o[16];
#pragma unroll
        for (int i = 0; i < 16; ++i) y[i] = fmaf(ALPHA, xr[i], outv[i]);
        ln_row(y, g2, b2, lane, o);
        store_row16(Xout + (size_t)tok * D, XBout ? XBout + (size_t)tok * D : nullptr, lane, o);
    }
}

__global__ void __launch_bounds__(NWAVES * 64, 2) hybrid_fwd(Ptrs A) {
    extern __shared__ __attribute__((aligned(16))) unsigned char lds_raw[];
    LAS unsigned char* lds = (LAS unsigned char*)lds_raw;
    volatile LAS unsigned* MISC = (volatile LAS unsigned*)(lds + MISC_OFF);
    const int G = gridDim.x, bx = blockIdx.x, vcu = (G % 8 == 0) ? (bx % 8) * (G / 8) + bx / 8 : bx, NGW = G * NWAVES;
    const int wave = __builtin_amdgcn_readfirstlane(threadIdx.x >> 6);
#define LEADER() (opq(wave) == 0 && lane_id() == 0)
    for (int u = wave * 64 + lane_id(); u < (LDS_BYTES - LDSCTL_OFF) / 4; u += NWAVES * 64) ((LAS unsigned*)(lds + LDSCTL_OFF))[u] = 0u;
    __syncthreads();
    XcdBarrier bar = xcd_barrier_post((unsigned*)(A.ws + WS_CTL) + CW_BAR, MISC + 8, LEADER());

#ifndef NO_PRO
    prologue(A, lds, opq(vcu), NGW, opq(wave));
#endif
    xcd_barrier(bar, LEADER());

#pragma unroll 1
    for (int l = 0; l < DEPTH; ++l) {
#ifndef NO_G1
        { unsigned char* ws = opq_ptr(A.ws); const pg8::bf16_t* XB = (const pg8::bf16_t*)(ws + WS_XB);
          pg8::Gemm g{XB, (const pg8::bf16_t*)(ws + WS_WQKV) + (size_t)l * 1024 * 1024, M, 1024, D}; pg8::StaticOrder S; S.init(M, 1024, opq(G), opq(bx));
          pg8::EpiBf16<0> E{(pg8::bf16_t*)(ws + WS_QKV), 1024, nullptr, 0, 0, 1.f};
          pg8::gemm_phase<pg8::EpiBf16<0>, pg8::StaticOrder, true, true>(lds + RING_OFF, g, S, E, opq(wave)); }
#endif
        xcd_barrier(bar, LEADER());
#ifndef NO_PREP
        prep_phase(A, l, opq(vcu), NGW, opq(wave));
#endif
        xcd_barrier(bar, LEADER());
#ifndef NO_ATTN
        if (opq(G) == 256) attn_phase_simple(A.ws, opq(vcu), opq(wave));
#endif
        xcd_barrier(bar, LEADER());
#ifndef NO_G2
        { unsigned char* ws = opq_ptr(A.ws);
          pg8::Gemm g{(const pg8::bf16_t*)(ws + WS_OCAT), (const pg8::bf16_t*)(ws + WS_WBR) + (size_t)l * 3 * 1024 * 128, 3 * M, 3 * 1024, 128}; pg8::BranchOrder S{opq(G), opq(bx)};
          pg8::EpiBranch E{(pg8::bf16_t*)(ws + WS_P)};
          pg8::gemm_phase<pg8::EpiBranch, pg8::BranchOrder, true, true>(lds + RING_OFF, g, S, E, opq(wave)); }
#endif
        xcd_barrier(bar, LEADER());
#ifndef NO_G3
        { unsigned char* ws = opq_ptr(A.ws); const pg8::bf16_t* XB = (const pg8::bf16_t*)(ws + WS_XB);
          pg8::Gemm g{XB, (const pg8::bf16_t*)(ws + WS_WGATE) + (size_t)l * 3072 * 1024, M, 3072, D}; pg8::GateOrder S; S.so.init(M, 1024, opq(G), opq(bx));
          pg8::EpiMerge E{(const pg8::bf16_t*)(ws + WS_P), (pg8::bf16_t*)(ws + WS_QKV), M};
          pg8::gemm_phase<pg8::EpiMerge, pg8::GateOrder, true, true>(lds + RING_OFF, g, S, E, opq(wave)); }
#endif
        xcd_barrier(bar, LEADER());
#ifndef NO_G4
        { unsigned char* ws = opq_ptr(A.ws); const float* xin = (l == 0) ? A.in[0] : (const float*)(ws + WS_X);
          pg8::Gemm g{(const pg8::bf16_t*)(ws + WS_QKV), (const pg8::bf16_t*)(ws + WS_WOUT) + (size_t)l * 1024 * 1024, M, 1024, D}; pg8::StaticOrder S; S.init(M, 1024, opq(G), opq(bx));
          pg8::EpiResF32 E{xin, (float*)(ws + WS_Y), D, ALPHA};
          pg8::gemm_phase<pg8::EpiResF32, pg8::StaticOrder, true, true>(lds + RING_OFF, g, S, E, opq(wave)); }
#endif
        xcd_barrier(bar, LEADER());
#ifndef NO_LN1
        ln1_phase(A, l, opq(vcu), NGW, opq(wave));
#endif
        xcd_barrier(bar, LEADER());
#ifndef NO_G5
        { unsigned char* ws = opq_ptr(A.ws); const pg8::bf16_t* XB = (const pg8::bf16_t*)(ws + WS_XB);
          pg8::Gemm g{XB, (const pg8::bf16_t*)(ws + WS_WQ) + (size_t)l * 1024 * 1024, M, 1024, D}; pg8::StaticOrder S; S.init(M, 1024, opq(G), opq(bx));
          pg8::EpiBf16<0> E{(pg8::bf16_t*)(ws + WS_QP), 1024, nullptr, 0, 0, 1.f};
          pg8::gemm_phase<pg8::EpiBf16<0>, pg8::StaticOrder, true, true>(lds + RING_OFF, g, S, E, opq(wave)); }
#endif
        xcd_barrier(bar, LEADER());
#ifndef NO_PEER
        if (opq(G) == 256) peer_wave(A, l, opq(vcu), l == DEPTH - 1, opq(wave));
#endif
        if (l != DEPTH - 1) xcd_barrier(bar, LEADER());
    }
}

extern "C" void kernel_launch(void* const* d_in, const int* in_sizes, int n_in, void* d_out, int out_size, void* d_ws, size_t ws_size, hipStream_t stream) {
    static int grid = 0;
    if (grid == 0) {
        if (n_in != 19 || out_size != M * D || ws_size < WS_END) { fprintf(stderr, "kernel_launch: unexpected shapes (n_in %d, out %d, ws %zu); nothing launched\n", n_in, out_size, ws_size); grid = -1; return; }
        int dev = 0, cus = 0, per_cu = 0;
        if (hipGetDevice(&dev) != hipSuccess || hipDeviceGetAttribute(&cus, hipDeviceAttributeMultiprocessorCount, dev) != hipSuccess) { grid = -1; return; }
        if (hipFuncSetAttribute((const void*)hybrid_fwd, hipFuncAttributeMaxDynamicSharedMemorySize, LDS_BYTES) != hipSuccess) { fprintf(stderr, "kernel_launch: hipFuncSetAttribute failed\n"); grid = -1; return; }
        if (hipOccupancyMaxActiveBlocksPerMultiprocessor(&per_cu, (const void*)hybrid_fwd, NWAVES * 64, LDS_BYTES) != hipSuccess || per_cu < 1)
            fprintf(stderr, "kernel_launch: note: occupancy query reports %d workgroups per CU\n", per_cu);
        (void)hipGetLastError();
        grid = cus;
    }
    if (grid < 0) return;
    if (hipMemsetAsync((char*)d_ws + WS_CTL, 0, CTL_ZERO_BYTES, stream) != hipSuccess) return;
    Ptrs a{};
    for (int i = 0; i < 19; ++i) a.in[i] = (const float*)d_in[i];
    a.out = (float*)d_out; a.ws = (unsigned char*)d_ws;
    hipLaunchKernelGGL(hybrid_fwd, dim3(grid), dim3(NWAVES * 64), LDS_BYTES, stream, a);
}
```

```cpp
#include <hip/hip_runtime.h>
#include <cstdio>
#include <cstdint>
#include <cmath>
namespace pg8 {
#define PG8_LAS __attribute__((address_space(3)))
typedef unsigned short bf16_t;
typedef short bf16x8 __attribute__((ext_vector_type(8)));
typedef float f32x4 __attribute__((ext_vector_type(4)));
typedef unsigned u32x4 __attribute__((ext_vector_type(4)));
constexpr int BM = 256, BK = 64, HALF = 128, HTB = HALF * BK * 2  , STAGE_BYTES = 8 * HTB, NXCD = 8, WGM = 8;

__host__ __device__ __forceinline__ int lds_byte(int r, int c) { const int st = (r >> 4) * 2 + (c >> 5), rr = r & 15, cc = c & 31, ob = rr * 64 + cc * 2; return st * 1024 + (ob ^ (((ob >> 9) & 1) << 5)); }
__host__ __device__ __forceinline__ void stage_rc(int b, int& R, int& C) { const int st = b / 1024, sb = b % 1024, swz = sb ^ (((sb >> 9) & 1) << 5); R = (st >> 1) * 16 + swz / 64; C = (st & 1) * 32 + (swz % 64) / 2; }
__host__ __device__ __forceinline__ int perm32(int rho) { const int n = rho >> 4, i = rho & 15; return 8 * (i >> 2) + 4 * n + (i & 3); }

struct Unit { int pm, pn; };
struct Gemm { const bf16_t* A; const bf16_t* Bt; int M, N, K; };

struct StaticOrder {
    int nM, nN, nwg, G, c;
    __host__ __device__ void init(int M, int N, int G_, int c_) { nM = M / BM; nN = N / BM; nwg = nM * nN; G = G_; c = c_; }
    __host__ __device__ bool next(int i, Unit& u) const {
        const long L = (long)i * G + c; if (L >= nwg) return false;
        int wgid = (int)L; { const int q = nwg / NXCD, r = nwg % NXCD, xcd = wgid % NXCD, off = wgid / NXCD; wgid = (xcd < r ? xcd * (q + 1) : r * (q + 1) + (xcd - r) * q) + off; }
        const int nig = WGM * nN, gid = wgid / nig, fm = gid * WGM, gsz = (nM - fm) < WGM ? (nM - fm) : WGM;
        u.pm = fm + ((wgid % nig) % gsz); u.pn = (wgid % nig) / gsz; return true;
    }
    __device__ __forceinline__ void a_ready(const Unit&) const {}
    __device__ __forceinline__ void done(const Unit&) const {}
};

__device__ __forceinline__ unsigned cvt_pk_bf16(float lo, float hi) { unsigned r; asm volatile("v_cvt_pk_bf16_f32 %0, %1, %2" : "=v"(r) : "v"(lo), "v"(hi)); return r; }
typedef float f32x2 __attribute__((ext_vector_type(2)));
__device__ __forceinline__ f32x2 gelu_pk(f32x2 v) {
    const f32x2 av = __builtin_elementwise_abs(v), d = av * 0.2316418882f + 1.0f;
    f32x2 t; t.x = __builtin_amdgcn_rcpf(d.x); t.y = __builtin_amdgcn_rcpf(d.y);
    f32x2 q = t * 0.5307027145f + (-0.7265760135f); q = q * t + 0.7107068705f; q = q * t + (-0.142248368f); q = q * t + 0.127414796f; q = q * t;
    const f32x2 s = (v * v) * (-0.72134752044f);
    f32x2 e; e.x = __builtin_amdgcn_exp2f(s.x); e.y = __builtin_amdgcn_exp2f(s.y);
    const f32x2 m = v * (q * e), r = v - m;
    f32x2 o; o.x = v.x < 0.f ? m.x : r.x; o.y = v.y < 0.f ? m.y : r.y; return o;
}

template <int ACT  > struct EpiBf16 {
    static constexpr bool PERM = true, AFTER_DRAIN = false; static_assert(ACT == 0 || ACT == 1, "EpiBf16: ACT is 0 (none) or 1 (gelu_pk)");
    bf16_t* O; int ldc; const float* bias; int split_cols; size_t split_stride; float scale0;
    __device__ __forceinline__ void operator()(const f32x4 (&acc)[2][2][4][2], const Unit& u, int wr, int wc, int fr, int fq) const {
        const int row0 = u.pm * BM + wr * 64 + fr; int colt = u.pn * BM; bf16_t* base = O;
        float sc = 1.f; if (split_cols) { const int t = colt / split_cols; base += (size_t)t * split_stride; colt -= t * split_cols; if (t == 0) sc = scale0; }
        const int col0 = colt + wc * 32 + 8 * fq, bcol0 = u.pn * BM + wc * 32 + 8 * fq;
        f32x4 bv[2][2];
#pragma unroll
        for (int bj = 0; bj < 2; ++bj)
#pragma unroll
            for (int n = 0; n < 2; ++n) bv[bj][n] = bias ? *(const f32x4*)(bias + bcol0 + bj * HALF + 4 * n) : (f32x4){0.f, 0.f, 0.f, 0.f};
#pragma unroll
        for (int ai = 0; ai < 2; ++ai)
#pragma unroll
            for (int m = 0; m < 4; ++m) { bf16_t* rowp = base + (size_t)(row0 + ai * HALF + m * 16) * ldc + col0;
#pragma unroll
                for (int bj = 0; bj < 2; ++bj) { f32x4 v0 = acc[ai][bj][m][0] + bv[bj][0], v1 = acc[ai][bj][m][1] + bv[bj][1];
                    if (ACT == 1) { f32x2 a = gelu_pk((f32x2){v0[0], v0[1]}), b = gelu_pk((f32x2){v0[2], v0[3]}), c = gelu_pk((f32x2){v1[0], v1[1]}), d = gelu_pk((f32x2){v1[2], v1[3]});
                        v0 = (f32x4){a.x, a.y, b.x, b.y}; v1 = (f32x4){c.x, c.y, d.x, d.y}; }
                    v0 = v0 * sc; v1 = v1 * sc; u32x4 w; w.x = cvt_pk_bf16(v0[0], v0[1]); w.y = cvt_pk_bf16(v0[2], v0[3]); w.z = cvt_pk_bf16(v1[0], v1[1]); w.w = cvt_pk_bf16(v1[2], v1[3]);
                    *(u32x4*)(rowp + bj * HALF) = w; } }
    }
};
template <class Epi, class Sched, bool ALIGN_EPI = false, bool SP2 = false>
__device__ __forceinline__ void gemm_phase(PG8_LAS unsigned char* lds, const Gemm g, const Sched& S, const Epi& E, const int wid) {
    int lane_o; asm volatile("v_mbcnt_lo_u32_b32 %0, -1, 0\n\tv_mbcnt_hi_u32_b32 %0, -1, %0" : "=v"(lane_o));
    const int lane = lane_o, tid = wid * 64 + lane, wr = wid >> 2, wc = wid & 3, fr = lane & 15, fq = lane >> 4;
    const int K = g.K, nt = K / BK;
    unsigned voffA[2], voffB[2];
#pragma unroll
    for (int i = 0; i < 2; ++i) { int R, C; stage_rc(tid * 16 + i * 8192, R, C); const int Rb = Epi::PERM ? ((R & ~31) + perm32(R & 31)) : R;
        voffA[i] = (unsigned)(R * K + C) * 2u; voffB[i] = (unsigned)(Rb * K + C) * 2u; }
    const size_t kstep = (size_t)(BK * 2);
    const size_t hstep = (size_t)HALF * K * 2;
    const size_t tstep = 2 * hstep;
    const unsigned ldsw = (unsigned)wid * 1024u;
    const int aoff = lds_byte(wr * 64 + fr, fq * 8), boff = lds_byte(wc * 32 + fr, fq * 8);
#define PG8_SA(b, h) (((b) * 2 + (h)) * HTB)
#define PG8_SB(b, h) ((4 + (b) * 2 + (h)) * HTB)
#define PG8_STAGE(bufoff, gbase, voff) do { _Pragma("unroll") for (int _i = 0; _i < 2; ++_i) \
        __builtin_amdgcn_global_load_lds((const unsigned*)((const char*)(gbase) + (voff)[_i]), (PG8_LAS unsigned*)(lds + (bufoff) + ldsw + _i * 8192), 16, 0, 0); } while (0)
#define PG8_LDA(dst, b, h) do { _Pragma("unroll") for (int m = 0; m < 4; ++m) _Pragma("unroll") for (int k = 0; k < 2; ++k) dst[m][k] = *(const PG8_LAS bf16x8*)(lds + PG8_SA(b, h) + aoff + m * 2048 + k * 1024); } while (0)
#define PG8_LDB(dst, b, h) do { _Pragma("unroll") for (int n = 0; n < 2; ++n) _Pragma("unroll") for (int k = 0; k < 2; ++k) dst[n][k] = *(const PG8_LAS bf16x8*)(lds + PG8_SB(b, h) + boff + n * 2048 + k * 1024); } while (0)
#define PG8_MMA(ai, bj, At, Bt) do { __builtin_amdgcn_s_setprio(1); _Pragma("unroll") for (int m = 0; m < 4; ++m) _Pragma("unroll") for (int n = 0; n < 2; ++n) _Pragma("unroll") for (int k = 0; k < 2; ++k) \
        acc[ai][bj][m][n] = __builtin_amdgcn_mfma_f32_16x16x32_bf16(Bt[n][k], At[m][k], acc[ai][bj][m][n], 0, 0, 0); __builtin_amdgcn_s_setprio(0); } while (0)
#define PG8_WAIT_V(n) asm volatile("s_waitcnt vmcnt(" #n ")" ::: "memory")
#define PG8_WAIT_L(n) asm volatile("s_waitcnt lgkmcnt(" #n ")" ::: "memory")
#define PG8_BAR __builtin_amdgcn_s_barrier()
#define PG8_SCHED __builtin_amdgcn_sched_barrier(0)
    Unit cur, nxt; int ui = 0;
    if (!S.next(0, cur)) return;
    f32x4 acc[2][2][4][2];
#pragma unroll
    for (int a = 0; a < 2; ++a)
#pragma unroll
        for (int b = 0; b < 2; ++b)
#pragma unroll
            for (int m = 0; m < 4; ++m)
#pragma unroll
                for (int n = 0; n < 2; ++n) acc[a][b][m][n] = (f32x4){0.f, 0.f, 0.f, 0.f};
    bf16x8 At[4][2], B0[2][2], B1[2][2];
    const char* cA = (const char*)g.A + (size_t)cur.pm * tstep; const char* cB = (const char*)g.Bt + (size_t)cur.pn * tstep;
    S.a_ready(cur);
    if constexpr (SP2) {
        PG8_STAGE(PG8_SB(0, 0), cB, voffB); PG8_STAGE(PG8_SB(0, 1), cB + hstep, voffB); PG8_STAGE(PG8_SA(0, 0), cA, voffA); PG8_STAGE(PG8_SA(0, 1), cA + hstep, voffA);
        if (wr == 1) PG8_BAR;
        PG8_WAIT_V(2); PG8_BAR;
        PG8_STAGE(PG8_SB(1, 0), cB + kstep, voffB); PG8_STAGE(PG8_SA(1, 0), cA + kstep, voffA); PG8_STAGE(PG8_SB(1, 1), cB + hstep + kstep, voffB);
        PG8_WAIT_V(6); PG8_BAR;
    } else {
        PG8_STAGE(PG8_SB(0, 0), cB, voffB); PG8_STAGE(PG8_SA(0, 0), cA, voffA); PG8_STAGE(PG8_SB(0, 1), cB + hstep, voffB); PG8_STAGE(PG8_SA(0, 1), cA + hstep, voffA);
        if (wr == 1) PG8_BAR;
        PG8_WAIT_V(4); PG8_BAR;
        PG8_STAGE(PG8_SB(1, 0), cB + kstep, voffB); PG8_STAGE(PG8_SA(1, 0), cA + kstep, voffA); PG8_STAGE(PG8_SB(1, 1), cB + hstep + kstep, voffB);
        PG8_WAIT_V(6); PG8_BAR;
    }
    for (;;) {
        const bool has_next = S.next(ui + 1, nxt);
        const char* nA = has_next ? (const char*)g.A + (size_t)nxt.pm * tstep : cA; const char* nB = has_next ? (const char*)g.Bt + (size_t)nxt.pn * tstep : cB;
        for (int t = 0; t < nt; t += 2) {
            const bool last = (t == nt - 2);
            const char* a1 = cA + (size_t)(t + 1) * kstep;
            const char* a2 = last ? nA : cA + (size_t)(t + 2) * kstep; const char* b2 = last ? nB : cB + (size_t)(t + 2) * kstep;
            const char* a3 = a2 + kstep; const char* b3 = b2 + kstep;
            if (last && has_next) S.a_ready(nxt);
            if constexpr (SP2) {
            PG8_LDB(B0, 0, 0); PG8_LDB(B1, 0, 1); PG8_SCHED; PG8_LDA(At, 0, 0); PG8_STAGE(PG8_SA(1, 1), a1 + hstep, voffA);
            PG8_WAIT_V(8); PG8_WAIT_L(0); PG8_BAR; PG8_MMA(0, 0, At, B0); PG8_MMA(0, 1, At, B1); PG8_BAR; PG8_SCHED;
            PG8_LDA(At, 0, 1); PG8_STAGE(PG8_SB(0, 0), b2, voffB); PG8_STAGE(PG8_SB(0, 1), b2 + hstep, voffB); PG8_STAGE(PG8_SA(0, 0), a2, voffA);
            PG8_WAIT_V(8); PG8_WAIT_L(0); PG8_BAR; PG8_MMA(1, 0, At, B0); PG8_MMA(1, 1, At, B1); PG8_BAR; PG8_SCHED;
            PG8_LDB(B0, 1, 0); PG8_LDB(B1, 1, 1); PG8_SCHED; PG8_LDA(At, 1, 0); PG8_STAGE(PG8_SA(0, 1), a2 + hstep, voffA);
            PG8_WAIT_V(8); PG8_WAIT_L(0); PG8_BAR; PG8_MMA(0, 0, At, B0); PG8_MMA(0, 1, At, B1); PG8_BAR; PG8_SCHED;
            PG8_LDA(At, 1, 1); PG8_STAGE(PG8_SB(1, 0), b3, voffB); PG8_STAGE(PG8_SB(1, 1), b3 + hstep, voffB); PG8_STAGE(PG8_SA(1, 0), a3, voffA);
            PG8_WAIT_V(8); PG8_WAIT_L(0); PG8_BAR; PG8_MMA(1, 0, At, B0); PG8_MMA(1, 1, At, B1); PG8_BAR; PG8_SCHED;
            } else {
            PG8_LDB(B0, 0, 0); PG8_SCHED; PG8_LDA(At, 0, 0); PG8_STAGE(PG8_SA(1, 1), a1 + hstep, voffA);
            PG8_WAIT_L(8); PG8_BAR; PG8_WAIT_L(0); PG8_MMA(0, 0, At, B0); PG8_BAR; PG8_SCHED;
            PG8_LDB(B1, 0, 1); PG8_STAGE(PG8_SB(0, 0), b2, voffB);
            PG8_BAR; PG8_WAIT_L(0); PG8_MMA(0, 1, At, B1); PG8_BAR;
            PG8_LDA(At, 0, 1); PG8_STAGE(PG8_SA(0, 0), a2, voffA);
            PG8_BAR; PG8_WAIT_L(0); PG8_MMA(1, 0, At, B0); PG8_BAR; PG8_SCHED;
            PG8_STAGE(PG8_SB(0, 1), b2 + hstep, voffB);
            PG8_WAIT_V(6); PG8_BAR; PG8_MMA(1, 1, At, B1); PG8_BAR;
            PG8_LDB(B0, 1, 0); PG8_SCHED; PG8_LDA(At, 1, 0); PG8_STAGE(PG8_SA(0, 1), a2 + hstep, voffA);
            PG8_WAIT_L(8); PG8_BAR; PG8_WAIT_L(0); PG8_MMA(0, 0, At, B0); PG8_BAR; PG8_SCHED;
            PG8_LDB(B1, 1, 1); PG8_STAGE(PG8_SB(1, 0), b3, voffB);
            PG8_BAR; PG8_WAIT_L(0); PG8_MMA(0, 1, At, B1); PG8_BAR;
            PG8_LDA(At, 1, 1); PG8_STAGE(PG8_SA(1, 0), a3, voffA);
            PG8_BAR; PG8_WAIT_L(0); PG8_MMA(1, 0, At, B0); PG8_BAR; PG8_SCHED;
            PG8_STAGE(PG8_SB(1, 1), b3 + hstep, voffB);
            PG8_WAIT_V(6); PG8_BAR; PG8_MMA(1, 1, At, B1); PG8_BAR;
            }
        }
        if constexpr (ALIGN_EPI) { if (wr == 0) PG8_BAR; }
        if constexpr (!Epi::AFTER_DRAIN) { E(acc, cur, wr, wc, fr, fq); S.done(cur); }
        if (!has_next) break;
#pragma unroll
        for (int a = 0; a < 2; ++a)
#pragma unroll
            for (int b = 0; b < 2; ++b)
#pragma unroll
                for (int m = 0; m < 4; ++m)
#pragma unroll
                    for (int n = 0; n < 2; ++n) acc[a][b][m][n] = (f32x4){0.f, 0.f, 0.f, 0.f};
        cur = nxt; cA = nA; cB = nB; ++ui;
        if constexpr (ALIGN_EPI) { if (wr == 1) PG8_BAR; }
    }
    PG8_WAIT_V(0);
    if constexpr (!ALIGN_EPI) { if (wr == 0) PG8_BAR; }
    PG8_BAR;
    if constexpr (Epi::AFTER_DRAIN) { E.fused(acc, cur, wr, wc, fr, fq, lds, wid, lane); S.done(cur); }
#undef PG8_SA
#undef PG8_SB
#undef PG8_STAGE
#undef PG8_LDA
#undef PG8_LDB
#undef PG8_MMA
#undef PG8_WAIT_V
#undef PG8_WAIT_L
#undef PG8_BAR
#undef PG8_SCHED
}
}

namespace pg8 {
typedef unsigned u32x4e __attribute__((ext_vector_type(4)));
__device__ __forceinline__ float bf_lo(unsigned w) { return __uint_as_float(w << 16); }
__device__ __forceinline__ float bf_hi(unsigned w) { return __uint_as_float(w & 0xffff0000u); }
__device__ __forceinline__ float sigmoidf_(float x) { return __builtin_amdgcn_rcpf(1.0f + __expf(-x)); }

struct BranchOrder {
    int G, c;
    __device__ bool next(int i, Unit& u) const {
        const int L = i * G + c; if (L >= 1536) return false;
        const int b = L >> 9, r = L & 511; u.pm = b * 128 + (r >> 2); u.pn = b * 4 + (r & 3); return true;
    }
    __device__ __forceinline__ void a_ready(const Unit&) const {}
    __device__ __forceinline__ void done(const Unit&) const {}
};
struct GateOrder {
    StaticOrder so;
    __device__ bool next(int i, Unit& u) const {
        Unit t; if (!so.next(i / 3, t)) return false;
        u.pm = t.pm; u.pn = (i % 3) * 4 + t.pn; return true;
    }
    __device__ __forceinline__ void a_ready(const Unit&) const {}
    __device__ __forceinline__ void done(const Unit&) const {}
};
struct EpiMerge {
    static constexpr bool PERM = true, AFTER_DRAIN = false;
    const bf16_t* P; bf16_t* MIX; int Mrows;
    __device__ __forceinline__ void operator()(const f32x4 (&acc)[2][2][4][2], const Unit& u, int wr, int wc, int fr, int fq) const {
        const int b = u.pn >> 2, pc = u.pn & 3;
        const int row0 = u.pm * BM + wr * 64 + fr, col0 = pc * BM + wc * 32 + 8 * fq;
        const bf16_t* Pb = P + (size_t)b * Mrows * 1024;
#pragma unroll
        for (int ai = 0; ai < 2; ++ai)
#pragma unroll
            for (int m = 0; m < 4; ++m) { const size_t ro = (size_t)(row0 + ai * HALF + m * 16) * 1024 + col0;
#pragma unroll
                for (int bj = 0; bj < 2; ++bj) {
                    const f32x4 v0 = acc[ai][bj][m][0], v1 = acc[ai][bj][m][1];
                    const u32x4 pw = *(const u32x4*)(Pb + ro + bj * HALF);
                    float r[8];
                    r[0] = sigmoidf_(v0[0]) * bf_lo(pw.x); r[1] = sigmoidf_(v0[1]) * bf_hi(pw.x); r[2] = sigmoidf_(v0[2]) * bf_lo(pw.y); r[3] = sigmoidf_(v0[3]) * bf_hi(pw.y);
                    r[4] = sigmoidf_(v1[0]) * bf_lo(pw.z); r[5] = sigmoidf_(v1[1]) * bf_hi(pw.z); r[6] = sigmoidf_(v1[2]) * bf_lo(pw.w); r[7] = sigmoidf_(v1[3]) * bf_hi(pw.w);
                    if (b > 0) { const u32x4 mw = *(const u32x4*)(MIX + ro + bj * HALF);
                        r[0] += bf_lo(mw.x); r[1] += bf_hi(mw.x); r[2] += bf_lo(mw.y); r[3] += bf_hi(mw.y); r[4] += bf_lo(mw.z); r[5] += bf_hi(mw.z); r[6] += bf_lo(mw.w); r[7] += bf_hi(mw.w); }
                    u32x4 w; w.x = cvt_pk_bf16(r[0], r[1]); w.y = cvt_pk_bf16(r[2], r[3]); w.z = cvt_pk_bf16(r[4], r[5]); w.w = cvt_pk_bf16(r[6], r[7]);
                    *(u32x4*)(MIX + ro + bj * HALF) = w; } }
    }
};
struct EpiBranch {
    static constexpr bool PERM = true, AFTER_DRAIN = false;
    bf16_t* O;
    __device__ __forceinline__ void operator()(const f32x4 (&acc)[2][2][4][2], const Unit& u, int wr, int wc, int fr, int fq) const {
        const int row0 = u.pm * BM + wr * 64 + fr, col0 = (u.pn & 3) * BM + wc * 32 + 8 * fq;
#pragma unroll
        for (int ai = 0; ai < 2; ++ai)
#pragma unroll
            for (int m = 0; m < 4; ++m) { bf16_t* rowp = O + (size_t)(row0 + ai * HALF + m * 16) * 1024 + col0;
#pragma unroll
                for (int bj = 0; bj < 2; ++bj) { const f32x4 v0 = acc[ai][bj][m][0], v1 = acc[ai][bj][m][1];
                    u32x4 w; w.x = cvt_pk_bf16(v0[0], v0[1]); w.y = cvt_pk_bf16(v0[2], v0[3]); w.z = cvt_pk_bf16(v1[0], v1[1]); w.w = cvt_pk_bf16(v1[2], v1[3]);
                    *(u32x4*)(rowp + bj * HALF) = w; } }
    }
};
struct EpiResF32 {
    static constexpr bool PERM = false, AFTER_DRAIN = false;
    const float* base; float* out; int ldc; float alpha;
    __device__ __forceinline__ void operator()(const f32x4 (&acc)[2][2][4][2], const Unit& u, int wr, int wc, int fr, int fq) const {
        const int col0 = u.pn * BM + wc * 32 + 4 * fq;
#pragma unroll
        for (int ai = 0; ai < 2; ++ai)
#pragma unroll
            for (int m = 0; m < 4; ++m) { const size_t off = (size_t)(u.pm * BM + ai * HALF + wr * 64 + m * 16 + fr) * ldc + col0;
#pragma unroll
                for (int bj = 0; bj < 2; ++bj)
#pragma unroll
                    for (int n = 0; n < 2; ++n) { const f32x4 bs = *(const f32x4*)(base + off + bj * HALF + n * 16); *(f32x4*)(out + off + bj * HALF + n * 16) = bs * alpha + acc[ai][bj][m][n]; } }
    }
};
}
#define GAS __attribute__((address_space(1)))
#define LAS __attribute__((address_space(3)))
#define XB_TMO      128
#define XB_XCNT(j)  (256  + 64 * (j))
#define XB_XSUB(j)  (1280 + 64 * (j))
#define XB_XGEN(j)  (2304 + 64 * (j))
#define XB_TOP      3328
#define XB_TOPGEN   3392
#define XCD_BAR_WORDS 3456
#define XB_SPIN_CAP (1u << 18)

__device__ __forceinline__ unsigned xb_ld(unsigned* p)              { return __hip_atomic_load(p, __ATOMIC_RELAXED, __HIP_MEMORY_SCOPE_AGENT); }
__device__ __forceinline__ unsigned xb_add(unsigned* p, unsigned v) { return __hip_atomic_fetch_add(p, v, __ATOMIC_RELAXED, __HIP_MEMORY_SCOPE_AGENT); }
__device__ __forceinline__ unsigned xb_xcc_id() { return (unsigned)__builtin_amdgcn_s_getreg((3 << 11) | 20) & 0xFu; }
#define XB_SPIN(cond, bar) do { unsigned _sp = 0; while (cond) { __builtin_amdgcn_s_sleep(1); \
    if ((++_sp & 255u) == 0u) { if (xb_ld(&(bar)[XB_TMO])) break; if (_sp > XB_SPIN_CAP) { atomicAdd(&(bar)[XB_TMO], 1u); break; } } } } while (0)

struct XcdBarrier {
    unsigned* bar; unsigned x;
    volatile LAS unsigned* st;
};

__device__ __forceinline__ XcdBarrier xcd_barrier_post(unsigned* bar, volatile LAS unsigned* st, bool leader) {
    XcdBarrier b; b.bar = bar; b.x = xb_xcc_id(); b.st = st;
    if (leader) (void)xb_add(&bar[XB_XCNT(b.x)], 1u);
    return b;
}
__device__ __forceinline__ void xcd_barrier_complete(unsigned* bar, unsigned x, unsigned& nloc, unsigned& nx) {
    const unsigned G = gridDim.x * gridDim.y * gridDim.z;
    unsigned sum, cnt, mine, sp = 0u;
    for (;;) {
        sum = 0u; cnt = 0u; mine = 0u;
#pragma unroll
        for (unsigned j = 0; j < 16; ++j) { const unsigned c = xb_ld(&bar[XB_XCNT(j)]); sum += c; cnt += (c > 0u) ? 1u : 0u; mine = (j == x) ? c : mine; }
        if (sum == G) break;
        __builtin_amdgcn_s_sleep(1);
        if ((++sp & 255u) == 0u) { if (xb_ld(&bar[XB_TMO])) break; if (sp > XB_SPIN_CAP) { atomicAdd(&bar[XB_TMO], 1u); break; } }
    }
    nloc = mine > 0u ? mine : 1u; nx = cnt > 0u ? cnt : 1u;
}

__device__ __forceinline__ void xcd_barrier(const XcdBarrier& b, bool leader) {
    asm volatile("s_waitcnt vmcnt(0)" ::: "memory");
    __syncthreads();
    if (leader) {
        unsigned* bar = b.bar; unsigned bx_ = b.x; asm volatile("" : "+s"(bar), "+s"(bx_));
        __builtin_amdgcn_s_waitcnt(0);
        unsigned nloc = b.st[0], nx = b.st[1];
        if (nloc == 0u) { xcd_barrier_complete(bar, bx_, nloc, nx); b.st[0] = nloc; b.st[1] = nx; }
        const unsigned old = xb_add(&bar[XB_XSUB(bx_)], 1u);
        const unsigned gen = old / nloc;
        if (old + 1u == (gen + 1u) * nloc) {
            __builtin_amdgcn_fence(__ATOMIC_RELEASE, "agent");
            asm volatile("s_waitcnt vmcnt(0)" ::: "memory");
            const unsigned og = xb_add(&bar[XB_TOP], 1u);
            const unsigned tg = og / nx;
            if (og + 1u == (tg + 1u) * nx) xb_add(&bar[XB_TOPGEN], 1u);
            else XB_SPIN(xb_ld(&bar[XB_TOPGEN]) == tg, bar);
            __builtin_amdgcn_fence(__ATOMIC_ACQUIRE, "agent");
            xb_add(&bar[XB_XGEN(bx_)], 1u);
            asm volatile("s_waitcnt vmcnt(0)" ::: "memory");
        } else {
            XB_SPIN(xb_ld(&bar[XB_XGEN(bx_)]) == gen, bar);
            __builtin_amdgcn_fence(__ATOMIC_ACQUIRE, "agent");
            asm volatile("s_waitcnt vmcnt(0)" ::: "memory");
        }
    }
    __syncthreads();
}

constexpr int NWAVES = 8;
constexpr int BATCH = 2, SEQ = 16384, D = 1024, DEPTH = 4, M = BATCH * SEQ, INW = 3980, NEXP = 16384;
constexpr float ALPHA = 1.681792830507429f, LN_EPS = 1e-5f, QK_SCALE = 0.17677669529663687f, LOG2E = 1.4426950408889634f;
constexpr float ZC = QK_SCALE * LOG2E;
constexpr int C_SBQ = 0, C_SBK = 128, C_SBV = 256, C_NQ = 384, C_CK = 512, C_CV = 544, C_SK = 576, C_SV = 608, C_WK = 640, C_WV = 672, C_MQ = 704, C_MK = 832, C_MV = 864, C_NG = 896;

constexpr size_t MiB = 1u << 20;
constexpr size_t WS_CTL = 0, CTL_ZERO_BYTES = 1 * MiB;
constexpr size_t WS_WQKV = 1 * MiB;
constexpr size_t WS_WGATE = 9 * MiB;
constexpr size_t WS_WBR = 33 * MiB;
constexpr size_t WS_WOUT = 36 * MiB;
constexpr size_t WS_WQ = 44 * MiB;
constexpr size_t WS_PK = 52 * MiB;
constexpr size_t WS_KC = 53 * MiB;
constexpr size_t WS_VC = WS_KC + 256 * 1024;
constexpr size_t WS_KMEAN = WS_VC + 256 * 1024;
constexpr size_t WS_UT = 54 * MiB;
constexpr size_t WS_VT = 182 * MiB;
constexpr size_t WS_X = 310 * MiB;
constexpr size_t WS_X1 = 438 * MiB;
constexpr size_t WS_XB = 566 * MiB;
constexpr size_t WS_QKV = 630 * MiB;
constexpr size_t WS_OCAT = 694 * MiB;
constexpr size_t WS_P = 718 * MiB;
constexpr size_t WS_Y = WS_P, WS_QP = WS_P + 128 * MiB;
constexpr size_t WS_END = 910 * MiB;
constexpr int CW_BAR = 4096;

constexpr int RING_OFF = 0, RING_BYTES = 131072;
constexpr int LDSCTL_OFF = RING_BYTES, MISC_OFF = LDSCTL_OFF + 320;
constexpr int LDS_BYTES = 147456;

typedef unsigned short bf16;
typedef unsigned v4u __attribute__((ext_vector_type(4)));
typedef float f32x4 __attribute__((ext_vector_type(4)));
typedef short bf16x8 __attribute__((ext_vector_type(8)));
#define LDS_WAIT() asm volatile("s_waitcnt lgkmcnt(0)" ::: "memory")

__device__ __forceinline__ unsigned f2bf(float f) { unsigned u = __builtin_bit_cast(unsigned, f); return (u + 0x7fffu + ((u >> 16) & 1u)) >> 16; }
__device__ __forceinline__ unsigned pk2(float lo, float hi) { return f2bf(lo) | (f2bf(hi) << 16); }
__device__ __forceinline__ float bflo(unsigned w) { return __uint_as_float(w << 16); }
__device__ __forceinline__ float bfhi(unsigned w) { return __uint_as_float(w & 0xffff0000u); }
__device__ __forceinline__ float bf1(bf16 h) { return __uint_as_float((unsigned)h << 16); }
__device__ __forceinline__ void unpack8(const v4u w, float* o) { o[0] = bflo(w.x); o[1] = bfhi(w.x); o[2] = bflo(w.y); o[3] = bfhi(w.y); o[4] = bflo(w.z); o[5] = bfhi(w.z); o[6] = bflo(w.w); o[7] = bfhi(w.w); }
__device__ __forceinline__ void load32bf(const bf16* p, float* o) {
    const v4u* q = (const v4u*)p; const v4u a = q[0], b = q[1], c = q[2], d = q[3];
    unpack8(a, o); unpack8(b, o + 8); unpack8(c, o + 16); unpack8(d, o + 24);
}
__device__ __forceinline__ void load32f(const float* p, float* o) {
    const f32x4* q = (const f32x4*)p;
#pragma unroll
    for (int i = 0; i < 8; ++i) { const f32x4 v = q[i]; o[4 * i] = v.x; o[4 * i + 1] = v.y; o[4 * i + 2] = v.z; o[4 * i + 3] = v.w; }
}
__device__ __forceinline__ void store32bf(bf16* p, const float* o) {
    v4u* q = (v4u*)p;
#pragma unroll
    for (int i = 0; i < 4; ++i) { v4u w; w.x = pk2(o[8 * i], o[8 * i + 1]); w.y = pk2(o[8 * i + 2], o[8 * i + 3]); w.z = pk2(o[8 * i + 4], o[8 * i + 5]); w.w = pk2(o[8 * i + 6], o[8 * i + 7]); q[i] = w; }
}
__device__ __forceinline__ float dot32(const float* a, const float* b) {
    float s0 = 0.f, s1 = 0.f, s2 = 0.f, s3 = 0.f;
#pragma unroll
    for (int i = 0; i < 32; i += 4) { s0 = fmaf(a[i], b[i], s0); s1 = fmaf(a[i + 1], b[i + 1], s1); s2 = fmaf(a[i + 2], b[i + 2], s2); s3 = fmaf(a[i + 3], b[i + 3], s3); }
    return (s0 + s1) + (s2 + s3);
}
__device__ __forceinline__ float ex2(float x) { return __builtin_amdgcn_exp2f(x); }
__device__ __forceinline__ float lg2(float x) { return __builtin_amdgcn_logf(x); }
__device__ __forceinline__ float shx(float v, int mask, int lane) { return __int_as_float(__builtin_amdgcn_ds_bpermute((lane ^ mask) << 2, __float_as_int(v))); }
__device__ __forceinline__ int shxi(int v, int mask, int lane) { return __builtin_amdgcn_ds_bpermute((lane ^ mask) << 2, v); }
__device__ __forceinline__ float wave_sum(float v, int lane) {
#pragma unroll
    for (int o = 1; o < 64; o <<= 1) v += shx(v, o, lane);
    return v;
}
__device__ __forceinline__ float quad_sum(float v, int lane) { v += shx(v, 1, lane); v += shx(v, 2, lane); return v; }
__device__ __forceinline__ int lane_id() { int l; asm volatile("v_mbcnt_lo_u32_b32 %0, -1, 0\n\tv_mbcnt_hi_u32_b32 %0, -1, %0" : "=v"(l)); return l; }
__device__ __forceinline__ int opq(int v) { asm volatile("" : "+s"(v)); return v; }
__device__ __forceinline__ unsigned char* opq_ptr(unsigned char* p) { asm volatile("" : "+s"(p)); return p; }
__device__ __forceinline__ int lane_zero() { int z; asm volatile("v_mov_b32 %0, 0" : "=v"(z)); return z; }

struct Ptrs {
    const float* in[19]; float* out; unsigned char* ws;
};

__device__ __forceinline__ void tr_item(const float* W, int pitch, int scol, int ncols, int K, int k0, bf16* WT, int drow0, LAS float* scr, int lane) {
#pragma unroll 8
    for (int i = 0; i < 32; ++i) { const int kk = 2 * i + (lane >> 5), c = lane & 31; scr[kk * 33 + c] = (c < ncols) ? W[(size_t)(k0 + kk) * pitch + scol + c] : 0.f; }
    LDS_WAIT(); asm volatile("" ::: "memory");
    const int c8 = lane & 7;
#pragma unroll
    for (int j = 0; j < 4; ++j) { const int n = (lane >> 3) + 8 * j; const LAS float* s = scr + (8 * c8) * 33 + n;
        v4u o; o.x = pk2(s[0 * 33], s[1 * 33]); o.y = pk2(s[2 * 33], s[3 * 33]); o.z = pk2(s[4 * 33], s[5 * 33]); o.w = pk2(s[6 * 33], s[7 * 33]);
        *(v4u*)(WT + (size_t)(drow0 + n) * K + k0 + 8 * c8) = o; }
    LDS_WAIT(); asm volatile("" ::: "memory");
}
__device__ __forceinline__ void cvt8(const float* src, bf16* dst) {
    const f32x4 a = *(const f32x4*)src, b = *(const f32x4*)(src + 4);
    v4u w; w.x = pk2(a.x, a.y); w.y = pk2(a.z, a.w); w.z = pk2(b.x, b.y); w.w = pk2(b.z, b.w); *(v4u*)dst = w;
}
__device__ __forceinline__ void prologue(const Ptrs& A, LAS unsigned char* lds, int vcu, int NGW, int wave) {
    const int lane = lane_id(), gw = vcu * NWAVES + wave;
    LAS float* scr = (LAS float*)(lds + RING_OFF + wave * 16384);
    unsigned char* ws = opq_ptr(A.ws);
    constexpr int IT_QKV = 16 * 32, IT_GATE = 16 * 96, IT_BR = 2 * 32, IT_OUT = 16 * 32, IT_WQ = 16 * 32, IT_L = IT_QKV + IT_GATE + 3 * IT_BR + IT_OUT + IT_WQ;
    for (int it = gw; it < DEPTH * IT_L; it += NGW) {
        const int l = it / IT_L; int r = it % IT_L;
        if (r < IT_QKV) { const int kb = r >> 5, di = r & 31; int scol, nc;
            if (di < 22) { scol = 32 * di; nc = 32; } else if (di < 26) { scol = 716 + 32 * (di - 22); nc = 32; } else if (di == 26) { scol = 844; nc = 32; } else if (di == 27) { scol = 876; nc = 32; }
            else if (di == 28) { scol = 704; nc = 12; } else { scol = 0; nc = 0; }
            tr_item(A.in[1] + (size_t)l * D * INW, INW, scol, nc, D, kb * 64, (bf16*)(ws + WS_WQKV) + (size_t)l * 1024 * 1024, di * 32, scr, lane); continue; }
        r -= IT_QKV;
        if (r < IT_GATE) { const int kb = r / 96, ni = r % 96;
            tr_item(A.in[1] + (size_t)l * D * INW, INW, 908 + 32 * ni, 32, D, kb * 64, (bf16*)(ws + WS_WGATE) + (size_t)l * 3072 * 1024, ni * 32, scr, lane); continue; }
        r -= IT_GATE;
        if (r < 3 * IT_BR) { const int b = r / IT_BR, q = r % IT_BR, kb = q >> 5, ni = q & 31;
            tr_item(A.in[6 + b] + (size_t)l * 128 * D, D, 32 * ni, 32, 128, kb * 64, (bf16*)(ws + WS_WBR) + (size_t)(l * 3 + b) * 1024 * 128, ni * 32, scr, lane); continue; }
        r -= 3 * IT_BR;
        if (r < IT_OUT) { const int kb = r >> 5, ni = r & 31;
            tr_item(A.in[9] + (size_t)l * D * D, D, 32 * ni, 32, D, kb * 64, (bf16*)(ws + WS_WOUT) + (size_t)l * 1024 * 1024, ni * 32, scr, lane); continue; }
        r -= IT_OUT;
        { const int kb = r >> 5, ni = r & 31;
            tr_item(A.in[12] + (size_t)l * D * D, D, 32 * ni, 32, D, kb * 64, (bf16*)(ws + WS_WQ) + (size_t)l * 1024 * 1024, ni * 32, scr, lane); }
    }
    const size_t gt = (size_t)gw * 64 + lane, NT = (size_t)NGW * 64;
    { const size_t n8 = (size_t)DEPTH * NEXP * D / 8; bf16* ut = (bf16*)(ws + WS_UT); bf16* vt = (bf16*)(ws + WS_VT);
      for (size_t i = gt; i < n8; i += NT) { cvt8(A.in[15] + i * 8, ut + i * 8); cvt8(A.in[16] + i * 8, vt + i * 8); } }
    { const size_t n8 = (size_t)M * D / 8; bf16* xb = (bf16*)(ws + WS_XB);
      for (size_t i = gt; i < n8; i += NT) cvt8(A.in[0] + i * 8, xb + i * 8); }
    { const size_t n8 = (size_t)DEPTH * 4 * 128 * 128 / 8; bf16* pk = (bf16*)(ws + WS_PK);
      for (size_t i = gt; i < n8; i += NT) { const size_t e = i * 8, lh = e >> 14, rest = e & 16383;
          cvt8(A.in[13] + e, pk + (lh * 2 + 0) * 16384 + rest); cvt8(A.in[14] + e, pk + (lh * 2 + 1) * 16384 + rest); } }
}

__device__ __forceinline__ void prep_phase(const Ptrs& A, int l, int vcu, int NGW, int wave) {
    const int lane = lane_id(), gw = vcu * NWAVES + wave;
    unsigned char* ws = opq_ptr(A.ws); const bf16* QKV = (const bf16*)(ws + WS_QKV);
    const int d = lane & 31, hf = lane >> 5, lz = lane_zero();
    for (int it = gw; it < 4092 + 128; it += NGW) {
        if (it < 4092) {
            const int kv = it / 2046, rr = it % 2046, b = rr / 1023, n = rr % 1023;
            const float* pe = A.in[kv ? 3 : 2] + (size_t)l * 1024; const float* w = A.in[kv ? 5 : 4] + (size_t)l * 1024 * 32;
            float acc = 0.f;
            for (int jj = 0; jj < 16; ++jj) { const int j = hf * 16 + jj; float c[32];
                load32bf(QKV + (size_t)(b * SEQ + 16 * n + j) * 1024 + (kv ? C_CV : C_CK) + lz, c);
#pragma unroll
                for (int e = 0; e < 32; ++e) acc = fmaf(c[e] + pe[j * 32 + e], w[(size_t)(j * 32 + e) * 32 + d], acc); }
            acc += shx(acc, 32, lane);
            if (hf == 0) ((float*)(ws + (kv ? WS_VC : WS_KC)))[(size_t)(b * 1024 + n) * 32 + d] = acc;
        } else {
            const int r = it - 4092, b = r >> 6, blk = r & 63; float s = 0.f;
            const bf16* p = QKV + (size_t)(b * SEQ + blk * 256 + hf * 128) * 1024 + C_MK + d;
            for (int i = 0; i < 128; ++i) s += bf1(p[(size_t)i * 1024]);
            s += shx(s, 32, lane);
            if (hf == 0) ((float*)(ws + WS_KMEAN))[(size_t)(b * 64 + blk) * 32 + d] = s * (1.0f / 256.0f);
        }
    }
}

struct OnlineSm { float m, l; };
__device__ __forceinline__ void osm_step(OnlineSm& s, float* o, float z2, bool valid, const float* v) {
    const float mn = valid ? fmaxf(s.m, z2) : s.m;
    const float a = ex2(s.m - mn);
    const float al = (s.m == mn) ? 1.0f : a;
    const float p = valid ? ex2(z2 - mn) : 0.f;
    s.l = s.l * al + p; s.m = mn;
#pragma unroll
    for (int i = 0; i < 32; ++i) o[i] = fmaf(p, v[i], o[i] * al);
}

__device__ __forceinline__ void sb_item(unsigned char* ws, int item, int lane) {
    const bf16* QKV = (const bf16*)(ws + WS_QKV); bf16* OSB = (bf16*)(ws + WS_OCAT);
    const int b = item >> 10, h = (item >> 8) & 3, g = item & 255, t = g * 64 + lane, lz = lane_zero();
    float q[32], o[32];
    load32bf(QKV + (size_t)(b * SEQ + t) * 1024 + C_SBQ + h * 32, q);
#pragma unroll
    for (int i = 0; i < 32; ++i) o[i] = 0.f;
    float carry = 0.f;
    const bf16* kb = QKV + (size_t)b * SEQ * 1024 + C_SBK + h * 32 + lz; const bf16* vb = QKV + (size_t)b * SEQ * 1024 + C_SBV + h * 32 + lz;
    for (int s = g * 64 + 62; s >= 0; --s) {
        float k[32], v[32];
        load32bf(kb + (size_t)s * 1024, k); load32bf(vb + (size_t)s * 1024, v);
        const float z2 = dot32(q, k) * ZC;
        const float sp = fmaxf(z2, 0.f) + lg2(1.0f + ex2(-fabsf(z2)));
        const bool valid = s < t;
        const float w = valid ? ex2(z2 - sp + carry) : 0.f;
        carry -= valid ? sp : 0.f;
#pragma unroll
        for (int i = 0; i < 32; ++i) o[i] = fmaf(w, v[i], o[i]);
        if (__all(carry < -151.0f)) break;
    }
    store32bf(OSB + (size_t)(b * SEQ + t) * 128 + h * 32, o);
}

__device__ __forceinline__ void nsa_item(unsigned char* ws, int b, int tg, int lane) {
    const bf16* QKV = (const bf16*)(ws + WS_QKV); bf16* ONSA = (bf16*)(ws + WS_OCAT) + (size_t)M * 128;
    const float* KC = (const float*)(ws + WS_KC) + (size_t)b * 1024 * 32; const float* VC = (const float*)(ws + WS_VC) + (size_t)b * 1024 * 32;
    const int t0 = tg * 16, h = lane & 3, t = t0 + (lane >> 2), lz = lane_zero(), cur = t >> 6;
    const size_t row = (size_t)(b * SEQ + t) * 1024;
    const float slope2 = LOG2E * (h == 0 ? 0.5f : h == 1 ? 0.125f : h == 2 ? 0.03125f : 0.0078125f);
    float q[32], out[32];
    load32bf(QKV + row + C_NQ + h * 32, q);
    const float g0 = 1.0f / (1.0f + __expf(-bf1(QKV[row + C_NG + h * 3 + 0]))), g1 = 1.0f / (1.0f + __expf(-bf1(QKV[row + C_NG + h * 3 + 1]))), g2 = 1.0f / (1.0f + __expf(-bf1(QKV[row + C_NG + h * 3 + 2])));
    const int ncnt = (t0 + 15 >= 31) ? ((t0 + 15 - 31) >> 4) + 1 : 0;
    float m = -INFINITY, l = 0.f;
    for (int n = 0; n < ncnt; ++n) { float k[32]; load32f(KC + (size_t)n * 32 + lz, k);
        const int dc = t - (16 * n + 31); const float z2 = dot32(q, k) * ZC - slope2 * (float)dc;
        if (dc >= 0) { const float mn = fmaxf(m, z2); l = l * ((m == mn) ? 1.0f : ex2(m - mn)) + ex2(z2 - mn); m = mn; } }
    const float inv_l = (l > 0.f) ? 1.0f / l : 0.f;
    float tv[5], o[32]; int ti[5];
#pragma unroll
    for (int i = 0; i < 5; ++i) { tv[i] = -1.0f; ti[i] = -1; }
#pragma unroll
    for (int i = 0; i < 32; ++i) o[i] = 0.f;
    float Pprev = 0.f, acc = 0.f;
    for (int n = 0; n < ncnt; ++n) { float k[32], v[32]; load32f(KC + (size_t)n * 32 + lz, k); load32f(VC + (size_t)n * 32 + lz, v);
        const int dc = t - (16 * n + 31); const float z2 = dot32(q, k) * ZC - slope2 * (float)dc;
        const float p = (dc >= 0) ? ex2(z2 - m) * inv_l : 0.f;
#pragma unroll
        for (int i = 0; i < 32; ++i) o[i] = fmaf(p, v[i], o[i]);
        const float P = quad_sum(p, lane); const int r = n & 3, j = n >> 2;
        acc = (r == 0) ? (Pprev + 2.0f * P) : (r == 3 ? acc + P : acc + 2.0f * P);
        Pprev = P;
        if (r == 3) {
            const bool ins = (j >= 1) && (j <= cur - 2) && (acc > tv[4]);
            tv[4] = ins ? acc : tv[4]; ti[4] = ins ? j : ti[4];
#pragma unroll
            for (int kk = 4; kk >= 1; --kk) { const bool sw = tv[kk] > tv[kk - 1];
                const float fa = tv[kk], fb = tv[kk - 1]; const int ia = ti[kk], ib = ti[kk - 1];
                tv[kk - 1] = sw ? fa : fb; tv[kk] = sw ? fb : fa; ti[kk - 1] = sw ? ia : ib; ti[kk] = sw ? ib : ia; }
        }
    }
#pragma unroll
    for (int i = 0; i < 32; ++i) out[i] = g0 * o[i];
    {
        OnlineSm sm{-INFINITY, 0.f};
#pragma unroll
        for (int i = 0; i < 32; ++i) o[i] = 0.f;
        const bf16* kb = QKV + (size_t)b * SEQ * 1024 + C_SK; const bf16* vb = QKV + (size_t)b * SEQ * 1024 + C_SV;
        for (int slot = 0; slot < 8; ++slot) {
            const int blk = slot == 0 ? 0 : slot == 1 ? (cur >= 2 ? cur - 1 : -1) : slot == 2 ? (cur >= 1 ? cur : -1) : slot == 3 ? ti[0] : slot == 4 ? ti[1] : slot == 5 ? ti[2] : slot == 6 ? ti[3] : ti[4];
            if (__all(blk < 0)) continue;
            const int bb = blk < 0 ? 0 : blk;
            for (int kk = 0; kk < 64; ++kk) { const int pos = bb * 64 + kk; float k[32], v[32];
                load32bf(kb + (size_t)pos * 1024, k); load32bf(vb + (size_t)pos * 1024, v);
                const float z2 = dot32(q, k) * ZC - slope2 * (float)(t - pos);
                osm_step(sm, o, z2, blk >= 0 && pos <= t, v); }
        }
        const float il = 1.0f / sm.l;
#pragma unroll
        for (int i = 0; i < 32; ++i) out[i] = fmaf(g1 * il, o[i], out[i]);
    }
    {
        OnlineSm sm{-INFINITY, 0.f};
#pragma unroll
        for (int i = 0; i < 32; ++i) o[i] = 0.f;
        const bf16* kb = QKV + (size_t)b * SEQ * 1024 + C_WK + lz; const bf16* vb = QKV + (size_t)b * SEQ * 1024 + C_WV + lz;
        const int p0 = (t0 - 511 > 0) ? t0 - 511 : 0;
        for (int pos = p0; pos <= t0 + 15; ++pos) { float k[32], v[32];
            load32bf(kb + (size_t)pos * 1024, k); load32bf(vb + (size_t)pos * 1024, v);
            const int dw = t - pos; const float z2 = dot32(q, k) * ZC - slope2 * (float)dw;
            osm_step(sm, o, z2, dw >= 0 && dw < 512, v); }
        const float il = 1.0f / sm.l;
#pragma unroll
        for (int i = 0; i < 32; ++i) out[i] = fmaf(g2 * il, o[i], out[i]);
    }
    store32bf(ONSA + (size_t)(b * SEQ + t) * 128 + h * 32, out);
}

__device__ __forceinline__ void moba_item(unsigned char* ws, int b, int tg, int lane) {
    const bf16* QKV = (const bf16*)(ws + WS_QKV); bf16* OMB = (bf16*)(ws + WS_OCAT) + (size_t)2 * M * 128;
    const float* KM = (const float*)(ws + WS_KMEAN) + (size_t)b * 64 * 32;
    const int t0 = tg * 16, h = lane & 3, t = t0 + (lane >> 2), lz = lane_zero(), cur = t0 >> 8;
    const float slope2 = LOG2E * (h == 0 ? 0.25f : h == 1 ? 0.0625f : h == 2 ? 0.015625f : 0.00390625f);
    float q[32], o[32];
    load32bf(QKV + (size_t)(b * SEQ + t) * 1024 + C_MQ + h * 32, q);
    float tv[3]; int ti[3];
#pragma unroll
    for (int i = 0; i < 3; ++i) { tv[i] = -INFINITY; ti[i] = -1; }
    for (int n = 0; n < cur; ++n) { float k[32]; load32f(KM + (size_t)n * 32 + lz, k);
        const float sg = quad_sum(dot32(q, k), lane);
        const bool ins = sg > tv[2]; tv[2] = ins ? sg : tv[2]; ti[2] = ins ? n : ti[2];
#pragma unroll
        for (int kk = 2; kk >= 1; --kk) { const bool sw = tv[kk] > tv[kk - 1];
            const float fa = tv[kk], fb = tv[kk - 1]; const int ia = ti[kk], ib = ti[kk - 1];
            tv[kk - 1] = sw ? fa : fb; tv[kk] = sw ? fb : fa; ti[kk - 1] = sw ? ia : ib; ti[kk] = sw ? ib : ia; }
    }
    OnlineSm sm{-INFINITY, 0.f};
#pragma unroll
    for (int i = 0; i < 32; ++i) o[i] = 0.f;
    const bf16* kb = QKV + (size_t)b * SEQ * 1024 + C_MK; const bf16* vb = QKV + (size_t)b * SEQ * 1024 + C_MV;
    for (int slot = 0; slot < 3; ++slot) {
        const int blk = slot == 0 ? ti[0] : slot == 1 ? ti[1] : ti[2];
        if (__all(blk < 0)) continue;
        const int bb = blk < 0 ? 0 : blk;
        for (int kk = 0; kk < 256; ++kk) { const int pos = bb * 256 + kk; float k[32], v[32];
            load32bf(kb + (size_t)pos * 1024, k); load32bf(vb + (size_t)pos * 1024, v);
            const float z2 = dot32(q, k) * ZC - slope2 * (float)(t - pos);
            osm_step(sm, o, z2, blk >= 0, v); }
    }
    for (int pos = cur * 256; pos <= t0 + 15; ++pos) { float k[32], v[32];
        load32bf(kb + (size_t)pos * 1024 + lz, k); load32bf(vb + (size_t)pos * 1024 + lz, v);
        const float z2 = dot32(q, k) * ZC - slope2 * (float)(t - pos);
        osm_step(sm, o, z2, pos <= t, v); }
    const float il = 1.0f / sm.l;
#pragma unroll
    for (int i = 0; i < 32; ++i) o[i] *= il;
    store32bf(OMB + (size_t)(b * SEQ + t) * 128 + h * 32, o);
}

__device__ __forceinline__ void attn_phase_simple(unsigned char* ws_, int vcu, int wave) {
    unsigned char* ws = opq_ptr(ws_);
    const int lane = lane_id();
#ifndef NO_NSA
    { const int k = vcu * 4 + (wave & 3); if (wave < 4) nsa_item(ws, 0, k, lane); else nsa_item(ws, 1, 1023 - k, lane); }
#endif
#ifndef NO_MOBA
    { const int it = vcu * 8 + wave; moba_item(ws, it >> 10, it & 1023, lane); }
#endif
#ifndef NO_SB
    sb_item(ws, vcu * 8 + wave, lane);
#endif
}


constexpr size_t KRV_BR = (size_t)BATCH * SEQ * 32;
constexpr size_t WS_KR = 910 * MiB, WS_VF = 926 * MiB, WS_KMH = 942 * MiB, WS_KML = WS_KMH + 64 * 1024, WS_NACC = 943 * MiB  , WS_END2 = 959 * MiB;
typedef float f32x4a __attribute__((ext_vector_type(4)));
#define MFMA16(a, b, c) __builtin_amdgcn_mfma_f32_16x16x32_bf16(a, b, c, 0, 0, 0)
typedef const GAS bf16* gcb;
typedef GAS bf16* gb;
typedef unsigned u32x2 __attribute__((ext_vector_type(2)));
__device__ __forceinline__ bf16x8 ld8(gcb p) { return __builtin_bit_cast(bf16x8, *(const GAS v4u*)p); }
typedef float f32x2c __attribute__((ext_vector_type(2))); typedef __bf16 bf16x2c __attribute__((ext_vector_type(2)));
__device__ __forceinline__ unsigned cvtpk(float lo, float hi) { const f32x2c v = {lo, hi}; const bf16x2c b = __builtin_convertvector(v, bf16x2c); return __builtin_bit_cast(unsigned, b); }
__device__ __forceinline__ bf16x8 pack_p(const f32x4 p0, const f32x4 p1) { v4u w; w.x = cvtpk(p0[0], p0[1]); w.y = cvtpk(p0[2], p0[3]); w.z = cvtpk(p1[0], p1[1]); w.w = cvtpk(p1[2], p1[3]); return __builtin_bit_cast(bf16x8, w); }
__device__ __forceinline__ float max8(const f32x4 a, const f32x4 b) { return fmaxf(fmaxf(fmaxf(a[0], a[1]), fmaxf(a[2], a[3])), fmaxf(fmaxf(b[0], b[1]), fmaxf(b[2], b[3]))); }
__device__ __forceinline__ float quadall_max(float v, int lane) { v = fmaxf(v, shx(v, 16, lane)); v = fmaxf(v, shx(v, 32, lane)); return v; }
__device__ __forceinline__ float quadall_sum(float v, int lane) { v += shx(v, 16, lane); v += shx(v, 32, lane); return v; }

__device__ __forceinline__ void prep2_phase(const Ptrs& A, int l, int vcu, int NGW, int wave) {
    const int lane = lane_id(), gw = vcu * NWAVES + wave;
    unsigned char* ws = opq_ptr(A.ws); const bf16* QKV = (const bf16*)(ws + WS_QKV);
    bf16* KR = (bf16*)(ws + WS_KR); bf16* VF = (bf16*)(ws + WS_VF);
    const int d = lane & 31, hf = lane >> 5, lz = lane_zero();
    constexpr int N_PACK = 7 * 2 * 512, N_CMP = 2 * 2 * 1024, N_KM = 128;
    for (int it = gw; it < N_PACK + N_CMP + N_KM; it += NGW) {
        if (it < N_PACK) {
            const int br = it >> 10, b = (it >> 9) & 1, g = it & 511;
            const int kcol = br == 0 ? C_WK : br == 1 ? C_SK : br == 2 ? C_MK : C_SBK + 32 * (br - 3), vcol = br == 0 ? C_WV : br == 1 ? C_SV : br == 2 ? C_MV : C_SBV + 32 * (br - 3);
            const bf16* src = QKV + (size_t)(b * SEQ + 32 * g) * 1024;
            { const int key = lane >> 1, half = lane & 1;
              const v4u x0 = *(const v4u*)(src + (size_t)key * 1024 + kcol + 16 * half), x1 = *(const v4u*)(src + (size_t)key * 1024 + kcol + 16 * half + 8);
              bf16* dst = KR + (size_t)br * KRV_BR + (size_t)(b * SEQ + 32 * g + key) * 32 + 16 * half; *(v4u*)dst = x0; *(v4u*)(dst + 8) = x1; }
            const int c = lane & 15, quad = lane >> 4;
#pragma unroll
            for (int dt = 0; dt < 2; ++dt) { unsigned short e[8];
#pragma unroll
                for (int j = 0; j < 8; ++j) { const int key = (j < 4) ? 4 * quad + j : 16 + 4 * quad + (j - 4); e[j] = src[(size_t)key * 1024 + vcol + 16 * dt + c]; }
                v4u w; w.x = e[0] | ((unsigned)e[1] << 16); w.y = e[2] | ((unsigned)e[3] << 16); w.z = e[4] | ((unsigned)e[5] << 16); w.w = e[6] | ((unsigned)e[7] << 16);
                *(v4u*)(VF + (size_t)br * KRV_BR + ((size_t)(b * 512 + g) * 2 + dt) * 512 + lane * 8) = w; }
        } else if (it < N_PACK + N_CMP) {
            const int r0 = it - N_PACK, kv = r0 >> 11, b = (r0 >> 10) & 1, n = r0 & 1023;
            float acc = 0.f;
            if (n < 1023) {
                const float* pe = A.in[kv ? 3 : 2] + (size_t)l * 1024; const float* w = A.in[kv ? 5 : 4] + (size_t)l * 1024 * 32;
                for (int jj = 0; jj < 16; ++jj) { const int j = hf * 16 + jj; float c[32];
                    load32bf(QKV + (size_t)(b * SEQ + 16 * n + j) * 1024 + (kv ? C_CV : C_CK) + lz, c);
#pragma unroll
                    for (int e = 0; e < 32; ++e) acc = fmaf(c[e] + pe[j * 32 + e], w[(size_t)(j * 32 + e) * 32 + d], acc); }
                acc += shx(acc, 32, lane);
            }
            if (hf == 0) {
                if (kv == 0) KR[(size_t)7 * KRV_BR + (size_t)(b * SEQ + n) * 32 + d] = (bf16)f2bf(acc);
                else { const int g = n >> 5, nn = n & 31, rr = nn & 15, quad = rr >> 2, jj = (rr & 3) + 4 * (nn >> 4), dt = d >> 4;
                       VF[(size_t)7 * KRV_BR + ((size_t)(b * 512 + g) * 2 + dt) * 512 + ((d & 15) + 16 * quad) * 8 + jj] = (bf16)f2bf(acc); }
            }
        } else {
            const int r = it - N_PACK - N_CMP, b = r >> 6, blk = r & 63; float s = 0.f;
            const bf16* p = QKV + (size_t)(b * SEQ + blk * 256 + hf * 128) * 1024 + C_MK + d;
            for (int i = 0; i < 128; ++i) s += bf1(p[(size_t)i * 1024]);
            s += shx(s, 32, lane);
            if (hf == 0) { const float mean = s * (1.0f / 256.0f); const unsigned hi = f2bf(mean); const float lo = mean - __uint_as_float(hi << 16);
                ((bf16*)(ws + WS_KMH))[(size_t)(b * 64 + blk) * 32 + d] = (bf16)hi; ((bf16*)(ws + WS_KML))[(size_t)(b * 64 + blk) * 32 + d] = (bf16)f2bf(lo); }
        }
    }
}

struct Col { f32x4 o0, o1; float m, l; };
__device__ __forceinline__ void col_init(Col& c) { c.o0 = (f32x4){0.f, 0.f, 0.f, 0.f}; c.o1 = c.o0; c.m = -INFINITY; c.l = 0.f; }
template <int KS, int MASK>
__device__ __forceinline__ void scores2(const bf16x8 a0, const bf16x8 a1, const bf16x8 qf, float slope2, int dist0, f32x4& z0, f32x4& z1) {
    const f32x4 zero = {0.f, 0.f, 0.f, 0.f};
    const f32x4 s0 = MFMA16(a0, qf, zero), s1 = MFMA16(a1, qf, zero);
#pragma unroll
    for (int r = 0; r < 4; ++r) { const int d0 = dist0 - KS * r, d1 = dist0 - KS * (16 + r);
        float x0 = fmaf(s0[r], ZC, -slope2 * (float)d0), x1 = fmaf(s1[r], ZC, -slope2 * (float)d1);
        if (MASK == 1) { x0 = d0 >= 0 ? x0 : -INFINITY; x1 = d1 >= 0 ? x1 : -INFINITY; }
        if (MASK == 2) { x0 = (d0 >= 0 && d0 < 512) ? x0 : -INFINITY; x1 = (d1 >= 0 && d1 < 512) ? x1 : -INFINITY; }
        z0[r] = x0; z1[r] = x1; }
}
__device__ __forceinline__ void col_update(Col& c, const f32x4 z0, const f32x4 z1, const bf16x8 v0, const bf16x8 v1, int lane) {
    const float tmax = quadall_max(max8(z0, z1), lane);
    const float mn = fmaxf(c.m, tmax), ms = (mn == -INFINITY) ? 0.f : mn;
    const float alpha = ex2(c.m - ms);
    f32x4 p0, p1; float s = 0.f;
#pragma unroll
    for (int r = 0; r < 4; ++r) { p0[r] = ex2(z0[r] - ms); p1[r] = ex2(z1[r] - ms); s += p0[r] + p1[r]; }
    c.l = fmaf(c.l, alpha, s); c.m = mn;
    c.o0 *= alpha; c.o1 *= alpha;
    const bf16x8 pb = pack_p(p0, p1);
    c.o0 = MFMA16(v0, pb, c.o0); c.o1 = MFMA16(v1, pb, c.o1);
}
__device__ __forceinline__ void col_merge(Col& c, float m2, float l2, const f32x4 a0, const f32x4 a1, int quad) {
    const float mn = fmaxf(c.m, m2), ms = (mn == -INFINITY) ? 0.f : mn;
    const float f1 = ex2(c.m - ms), f2 = ex2(m2 - ms);
    c.l = fmaf(c.l, f1, (quad == 0) ? l2 * f2 : 0.f); c.m = mn;
    c.o0 = c.o0 * f1 + a0 * f2; c.o1 = c.o1 * f1 + a1 * f2;
}

template <int K> struct TopK { float v[K]; int i[K]; };
template <int K> __device__ __forceinline__ void topk_init(TopK<K>& t) {
#pragma unroll
    for (int k = 0; k < K; ++k) { t.v[k] = -INFINITY; t.i[k] = -1; } }
template <int K> __device__ __forceinline__ void topk_insert(TopK<K>& t, float v, int idx, bool ok) {
    const bool ins = ok && (v > t.v[K - 1] || (v == t.v[K - 1] && idx < t.i[K - 1]));
    t.v[K - 1] = ins ? v : t.v[K - 1]; t.i[K - 1] = ins ? idx : t.i[K - 1];
#pragma unroll
    for (int k = K - 1; k >= 1; --k) { const bool sw = t.v[k] > t.v[k - 1] || (t.v[k] == t.v[k - 1] && t.i[k] >= 0 && (t.i[k - 1] < 0 || t.i[k] < t.i[k - 1]));
        const float fa = t.v[k], fb = t.v[k - 1]; const int ia = t.i[k], ib = t.i[k - 1];
        t.v[k - 1] = sw ? fa : fb; t.v[k] = sw ? fb : fa; t.i[k - 1] = sw ? ia : ib; t.i[k] = sw ? ib : ia; }
}

constexpr int AW_G = 0;
constexpr int AW_CAND = 16 * 4 * 36 * 4;
constexpr int AW_SEL = AW_CAND + 16 * 20 * 8;
constexpr int AW_BYTES = AW_SEL + 16 * 8 * 4;
static_assert(AW_BYTES * NWAVES <= RING_BYTES, "attention scratch fits the idle GEMM ring");

template <int NSLOT, int NB>
__device__ __forceinline__ void gathered_part(gcb Qrows  , int qcol, gcb KRb, gcb VFb  , LAS unsigned char* wl, int t0, const float slope2, int lane) {
    const int col = lane & 15, quad = lane >> 4, qi = col >> 2, h = col & 3;
    const LAS int* SEL = (const LAS int*)(wl + AW_SEL); LAS float* Gt = (LAS float*)(wl + AW_G);
#pragma unroll 1
    for (int g4 = 0; g4 < 4; ++g4) {
        const int ql = 4 * g4 + qi, tq = t0 + ql;
        const bf16x8 qf = ld8(Qrows + (size_t)tq * 1024 + qcol + h * 32 + quad * 8);
        Col c; col_init(c);
#pragma unroll 1
        for (int slot = 0; slot < NSLOT; ++slot) {
            const int blk = SEL[ql * 8 + slot];
            int bq[4];
#pragma unroll
            for (int k = 0; k < 4; ++k) bq[k] = __builtin_amdgcn_readfirstlane(SEL[(4 * g4 + k) * 8 + slot]);
            if (bq[0] < 0 && bq[1] < 0 && bq[2] < 0 && bq[3] < 0) continue;
#pragma unroll 1
            for (int st = 0; st < NB / 32; ++st) {
                f32x4 z0 = {0.f, 0.f, 0.f, 0.f}, z1 = z0;
#pragma unroll
                for (int k = 0; k < 4; ++k) { const int bb = bq[k] < 0 ? 0 : bq[k]; const size_t key0 = (size_t)bb * NB + 32 * st;
                    const bf16x8 a0 = ld8(KRb + (key0 + col) * 32 + quad * 8), a1 = ld8(KRb + (key0 + 16 + col) * 32 + quad * 8);
                    const f32x4 zero = {0.f, 0.f, 0.f, 0.f};
                    const f32x4 s0 = MFMA16(a0, qf, zero), s1 = MFMA16(a1, qf, zero);
                    if (qi == k) { z0 = s0; z1 = s1; }
                    __builtin_amdgcn_sched_barrier(0); }
                const int dist0 = tq - ((blk < 0 ? 0 : blk) * NB + 32 * st + 4 * quad);
#pragma unroll
                for (int r = 0; r < 4; ++r) { z0[r] = (blk >= 0) ? fmaf(z0[r], ZC, -slope2 * (float)(dist0 - r)) : -INFINITY; z1[r] = (blk >= 0) ? fmaf(z1[r], ZC, -slope2 * (float)(dist0 - 16 - r)) : -INFINITY; }
                const float tmax = quadall_max(max8(z0, z1), lane);
                const float mn = fmaxf(c.m, tmax), ms = (mn == -INFINITY) ? 0.f : mn, alpha = ex2(c.m - ms);
                f32x4 p0, p1; float s = 0.f;
#pragma unroll
                for (int r = 0; r < 4; ++r) { p0[r] = ex2(z0[r] - ms); p1[r] = ex2(z1[r] - ms); s += p0[r] + p1[r]; }
                c.l = fmaf(c.l, alpha, s); c.m = mn; c.o0 *= alpha; c.o1 *= alpha;
                const v4u pw = __builtin_bit_cast(v4u, pack_p(p0, p1));
#pragma unroll
                for (int k = 0; k < 4; ++k) { const int bb = bq[k] < 0 ? 0 : bq[k]; const size_t key0 = (size_t)bb * NB + 32 * st;
                    const bf16x8 vf0 = ld8(VFb + (key0 >> 5) * 1024 + lane * 8), vf1 = ld8(VFb + (key0 >> 5) * 1024 + 512 + lane * 8);
                    const unsigned msk = (qi == k) ? 0xffffffffu : 0u; v4u pm; pm.x = pw.x & msk; pm.y = pw.y & msk; pm.z = pw.z & msk; pm.w = pw.w & msk;
                    const bf16x8 pb = __builtin_bit_cast(bf16x8, pm);
                    c.o0 = MFMA16(vf0, pb, c.o0); c.o1 = MFMA16(vf1, pb, c.o1);
                    __builtin_amdgcn_sched_barrier(0); }
            }
        }
        const float lt = quadall_sum(c.l, lane);
        LAS float* gp = Gt + (ql * 4 + h) * 36;
        if (quad == 0) { gp[0] = c.m; gp[1] = lt; }
        *(LAS f32x4*)(gp + 4 + 4 * quad) = c.o0; *(LAS f32x4*)(gp + 4 + 16 + 4 * quad) = c.o1;
    }
    asm volatile("s_waitcnt lgkmcnt(0)" ::: "memory");
}

__device__ __forceinline__ void nsa_item2(unsigned char* ws_, LAS unsigned char* wl, int b, int tg, int lane) {
    GAS unsigned char* ws = (GAS unsigned char*)ws_;
    gcb QKV = (gcb)(ws + WS_QKV); gb ONSA = (gb)(ws + WS_OCAT) + (size_t)M * 128;
    gcb Qb = QKV + (size_t)b * SEQ * 1024;
    gcb KR = (gcb)(ws + WS_KR) + (size_t)b * SEQ * 32; gcb VF = (gcb)(ws + WS_VF) + (size_t)b * SEQ * 32;
    const int col = lane & 15, quad = lane >> 4, t0 = tg * 16, tq = t0 + col, cur = t0 >> 6;
    constexpr float SL[4] = {LOG2E * 0.5f, LOG2E * 0.125f, LOG2E * 0.03125f, LOG2E * 0.0078125f};
    bf16x8 qf[4];
#pragma unroll
    for (int h = 0; h < 4; ++h) qf[h] = ld8(Qb + (size_t)tq * 1024 + C_NQ + h * 32 + quad * 8);
    GAS float* NACC = (GAS float*)(ws + WS_NACC) + (size_t)(b * SEQ + tq) * 128 + 4 * quad;
#define NSA_GATE(h, k) (1.0f / (1.0f + __expf(-bf1(Qb[(size_t)tq * 1024 + C_NG + (h) * 3 + (k)]))))
    gcb KRc = KR + (size_t)7 * KRV_BR; gcb VFc = VF + (size_t)7 * KRV_BR;
    const int ngr = (t0 + 15 >= 31) ? ((((t0 + 15 - 31) >> 4) + 32) >> 5) : 0;
    float m1[4], l1[4];
#pragma unroll
    for (int h = 0; h < 4; ++h) { m1[h] = -INFINITY; l1[h] = 0.f; }
#pragma unroll 1
    for (int g = 0; g < ngr; ++g) {
        const bf16x8 a0 = ld8(KRc + (size_t)(32 * g + col) * 32 + quad * 8), a1 = ld8(KRc + (size_t)(32 * g + 16 + col) * 32 + quad * 8);
        const int dist0 = tq - 31 - 16 * (32 * g + 4 * quad);
#pragma unroll
        for (int h = 0; h < 4; ++h) { f32x4 z0, z1; scores2<16, 1>(a0, a1, qf[h], SL[h], dist0, z0, z1);
            const float tmax = quadall_max(max8(z0, z1), lane); const float mn = fmaxf(m1[h], tmax), ms = (mn == -INFINITY) ? 0.f : mn;
            float s = 0.f;
#pragma unroll
            for (int r = 0; r < 4; ++r) s += ex2(z0[r] - ms) + ex2(z1[r] - ms);
            l1[h] = fmaf(l1[h], ex2(m1[h] - ms), s); m1[h] = mn; }
    }
    float il[4];
#pragma unroll
    for (int h = 0; h < 4; ++h) { const float lt = quadall_sum(l1[h], lane); il[h] = lt > 0.f ? 1.0f / lt : 0.f; m1[h] = (m1[h] == -INFINITY) ? 0.f : m1[h]; }
    TopK<5> tk; topk_init(tk);
    f32x4 oc0[4], oc1[4];
#pragma unroll
    for (int h = 0; h < 4; ++h) { oc0[h] = (f32x4){0.f, 0.f, 0.f, 0.f}; oc1[h] = oc0[h]; }
    float tail_carry = 0.f;
#pragma unroll 1
    for (int g = 0; g < ngr; ++g) {
        const bf16x8 a0 = ld8(KRc + (size_t)(32 * g + col) * 32 + quad * 8), a1 = ld8(KRc + (size_t)(32 * g + 16 + col) * 32 + quad * 8);
        const bf16x8 v0 = ld8(VFc + (size_t)g * 1024 + lane * 8), v1 = ld8(VFc + (size_t)g * 1024 + 512 + lane * 8);
        const int dist0 = tq - 31 - 16 * (32 * g + 4 * quad);
        f32x4 ps0 = {0.f, 0.f, 0.f, 0.f}, ps1 = ps0;
#pragma unroll
        for (int h = 0; h < 4; ++h) { f32x4 z0, z1; scores2<16, 1>(a0, a1, qf[h], SL[h], dist0, z0, z1);
            f32x4 p0, p1;
#pragma unroll
            for (int r = 0; r < 4; ++r) { p0[r] = ex2(z0[r] - m1[h]) * il[h]; p1[r] = ex2(z1[r] - m1[h]) * il[h]; }
            ps0 += p0; ps1 += p1;
            const bf16x8 pb = pack_p(p0, p1);
            oc0[h] = MFMA16(v0, pb, oc0[h]); oc1[h] = MFMA16(v1, pb, oc1[h]); __builtin_amdgcn_sched_barrier(0); }
        const float t0s = ps0[3], t1s = ps1[3];
        const float pv0 = shx(t0s, (quad == 0) ? 0 : 16 * ((quad - 1) ^ quad), lane);
        const float pv1 = shx(t1s, (quad == 0) ? 0 : 16 * ((quad - 1) ^ quad), lane);
        const float q3t0 = shx(t0s, 16 * (quad ^ 3), lane);
        const float q3t1 = shx(t1s, 16 * (quad ^ 3), lane);
        const float prev0 = (quad == 0) ? tail_carry : pv0, prev1 = (quad == 0) ? q3t0 : pv1;
        const float imp0 = prev0 + 2.0f * (ps0[0] + ps0[1] + ps0[2]) + ps0[3], imp1 = prev1 + 2.0f * (ps1[0] + ps1[1] + ps1[2]) + ps1[3];
        tail_carry = q3t1;
        const int j0 = 8 * g + quad, j1 = 8 * g + 4 + quad;
        topk_insert(tk, imp0, j0, j0 >= 1 && j0 <= cur - 2);
        topk_insert(tk, imp1, j1, j1 >= 1 && j1 <= cur - 2);
    }
#pragma unroll
    for (int h = 0; h < 4; ++h) { const float g0 = NSA_GATE(h, 0); *(GAS f32x4*)(NACC + h * 32) = oc0[h] * g0; *(GAS f32x4*)(NACC + h * 32 + 16) = oc1[h] * g0; }
    {
        LAS float* CV = (LAS float*)(wl + AW_CAND); LAS int* CI = (LAS int*)(wl + AW_CAND) + 1; LAS int* SEL = (LAS int*)(wl + AW_SEL);
#pragma unroll
        for (int k = 0; k < 5; ++k) { CV[((col * 4 + quad) * 5 + k) * 2] = tk.v[k]; CI[((col * 4 + quad) * 5 + k) * 2] = tk.i[k]; }
        asm volatile("s_waitcnt lgkmcnt(0)" ::: "memory");
        if (quad == 0) { TopK<5> fin; topk_init(fin);
            for (int e = 0; e < 20; ++e) { const float v = CV[(col * 20 + e) * 2]; const int i = CI[(col * 20 + e) * 2]; topk_insert(fin, v, i, i >= 0); }
#pragma unroll
            for (int k = 0; k < 5; ++k) SEL[col * 8 + k] = fin.i[k];
            int neg1; asm volatile("v_mov_b32 %0, -1" : "=v"(neg1));
            SEL[col * 8 + 5] = neg1; SEL[col * 8 + 6] = neg1; SEL[col * 8 + 7] = neg1; }
        asm volatile("s_waitcnt lgkmcnt(0)" ::: "memory");
    }
    gathered_part<5, 64>(Qb, C_NQ, KR + (size_t)1 * KRV_BR, VF + (size_t)1 * KRV_BR, wl, t0, LOG2E * ((lane & 3) == 0 ? 0.5f : (lane & 3) == 1 ? 0.125f : (lane & 3) == 2 ? 0.03125f : 0.0078125f), lane);
    {
        gcb KRs = KR + (size_t)1 * KRV_BR; gcb VFs = VF + (size_t)1 * KRV_BR;
        Col c[4];
#pragma unroll
        for (int h = 0; h < 4; ++h) col_init(c[h]);
#pragma unroll 1
        for (int f = 0; f < 3; ++f) {
            const int blk = f == 0 ? 0 : f == 1 ? (cur >= 2 ? cur - 1 : -1) : (cur >= 1 ? cur : -1);
            if (blk < 0) continue;
#pragma unroll 1
            for (int st = 0; st < 2; ++st) { const int key0 = blk * 64 + 32 * st;
                const bf16x8 a0 = ld8(KRs + (size_t)(key0 + col) * 32 + quad * 8), a1 = ld8(KRs + (size_t)(key0 + 16 + col) * 32 + quad * 8);
                const bf16x8 v0 = ld8(VFs + (size_t)(key0 >> 5) * 1024 + lane * 8), v1 = ld8(VFs + (size_t)(key0 >> 5) * 1024 + 512 + lane * 8);
                const int dist0 = tq - (key0 + 4 * quad);
#pragma unroll
                for (int h = 0; h < 4; ++h) { f32x4 z0, z1; scores2<1, 1>(a0, a1, qf[h], SL[h], dist0, z0, z1); col_update(c[h], z0, z1, v0, v1, lane); __builtin_amdgcn_sched_barrier(0); } }
        }
        const LAS float* Gt = (const LAS float*)(wl + AW_G);
#pragma unroll
        for (int h = 0; h < 4; ++h) { const LAS float* gp = Gt + (col * 4 + h) * 36;
            col_merge(c[h], gp[0], gp[1], *(const LAS f32x4*)(gp + 4 + 4 * quad), *(const LAS f32x4*)(gp + 4 + 16 + 4 * quad), quad);
            const float f = NSA_GATE(h, 1) / quadall_sum(c[h].l, lane);
            *(GAS f32x4*)(NACC + h * 32) += c[h].o0 * f; *(GAS f32x4*)(NACC + h * 32 + 16) += c[h].o1 * f; }
    }
    {
        gcb KRw = KR; gcb VFw = VF;
        Col c[4];
#pragma unroll
        for (int h = 0; h < 4; ++h) col_init(c[h]);
        const int g_lo = (t0 - 511 > 0) ? ((t0 - 511) >> 5) : 0, g_hi = (t0 + 15) >> 5;
#pragma unroll 1
        for (int g = g_lo; g <= g_hi; ++g) { const int key0 = 32 * g;
            const bf16x8 a0 = ld8(KRw + (size_t)(key0 + col) * 32 + quad * 8), a1 = ld8(KRw + (size_t)(key0 + 16 + col) * 32 + quad * 8);
            const bf16x8 v0 = ld8(VFw + (size_t)g * 1024 + lane * 8), v1 = ld8(VFw + (size_t)g * 1024 + 512 + lane * 8);
            const int dist0 = tq - (key0 + 4 * quad);
#pragma unroll
            for (int h = 0; h < 4; ++h) { f32x4 z0, z1; scores2<1, 2>(a0, a1, qf[h], SL[h], dist0, z0, z1); col_update(c[h], z0, z1, v0, v1, lane); __builtin_amdgcn_sched_barrier(0); }
        }
#pragma unroll
        for (int h = 0; h < 4; ++h) { const float f = NSA_GATE(h, 2) / quadall_sum(c[h].l, lane);
            const f32x4 x0 = *(GAS f32x4*)(NACC + h * 32) + c[h].o0 * f, x1 = *(GAS f32x4*)(NACC + h * 32 + 16) + c[h].o1 * f;
            gb op = ONSA + (size_t)(b * SEQ + tq) * 128 + h * 32 + 4 * quad;
            u32x2 w0, w1; w0.x = cvtpk(x0[0], x0[1]); w0.y = cvtpk(x0[2], x0[3]); w1.x = cvtpk(x1[0], x1[1]); w1.y = cvtpk(x1[2], x1[3]);
            *(GAS u32x2*)op = w0; *(GAS u32x2*)(op + 16) = w1; }
    }
}

__device__ __forceinline__ void moba_item2(unsigned char* ws_, LAS unsigned char* wl, int b, int tg, int lane) {
    GAS unsigned char* ws = (GAS unsigned char*)ws_;
    gcb QKV = (gcb)(ws + WS_QKV); gb OMB = (gb)(ws + WS_OCAT) + (size_t)2 * M * 128;
    gcb Qb = QKV + (size_t)b * SEQ * 1024;
    gcb KRm = (gcb)(ws + WS_KR) + (size_t)2 * KRV_BR + (size_t)b * SEQ * 32; gcb VFm = (gcb)(ws + WS_VF) + (size_t)2 * KRV_BR + (size_t)b * SEQ * 32;
    const int col = lane & 15, quad = lane >> 4, t0 = tg * 16, tq = t0 + col, cur = t0 >> 8;
    constexpr float SL[4] = {LOG2E * 0.25f, LOG2E * 0.0625f, LOG2E * 0.015625f, LOG2E * 0.00390625f};
    bf16x8 qf[4];
#pragma unroll
    for (int h = 0; h < 4; ++h) qf[h] = ld8(Qb + (size_t)tq * 1024 + C_MQ + h * 32 + quad * 8);
    {
        gcb KMH = (gcb)(ws + WS_KMH) + (size_t)b * 64 * 32; gcb KML = (gcb)(ws + WS_KML) + (size_t)b * 64 * 32;
        TopK<3> tk; topk_init(tk);
        const int nt = (cur + 15) >> 4;
#pragma unroll 1
        for (int T = 0; T < nt; ++T) {
            const bf16x8 ah = ld8(KMH + (size_t)(16 * T + col) * 32 + quad * 8), al = ld8(KML + (size_t)(16 * T + col) * 32 + quad * 8);
            f32x4 s = {0.f, 0.f, 0.f, 0.f};
#pragma unroll
            for (int h = 0; h < 4; ++h) { s = MFMA16(ah, qf[h], s); s = MFMA16(al, qf[h], s); }
#pragma unroll
            for (int r = 0; r < 4; ++r) { const int n = 16 * T + 4 * quad + r; topk_insert(tk, s[r], n, n < cur); }
        }
        LAS float* CV = (LAS float*)(wl + AW_CAND); LAS int* CI = (LAS int*)(wl + AW_CAND) + 1; LAS int* SEL = (LAS int*)(wl + AW_SEL);
#pragma unroll
        for (int k = 0; k < 3; ++k) { CV[((col * 4 + quad) * 3 + k) * 2] = tk.v[k]; CI[((col * 4 + quad) * 3 + k) * 2] = tk.i[k]; }
        asm volatile("s_waitcnt lgkmcnt(0)" ::: "memory");
        if (quad == 0) { TopK<3> fin; topk_init(fin);
            for (int e = 0; e < 12; ++e) { const float v = CV[(col * 12 + e) * 2]; const int i = CI[(col * 12 + e) * 2]; topk_insert(fin, v, i, i >= 0); }
#pragma unroll
            for (int k = 0; k < 3; ++k) SEL[col * 8 + k] = fin.i[k]; }
        asm volatile("s_waitcnt lgkmcnt(0)" ::: "memory");
    }
    gathered_part<3, 256>(Qb, C_MQ, KRm, VFm, wl, t0, LOG2E * ((lane & 3) == 0 ? 0.25f : (lane & 3) == 1 ? 0.0625f : (lane & 3) == 2 ? 0.015625f : 0.00390625f), lane);
    Col c[4];
#pragma unroll
    for (int h = 0; h < 4; ++h) col_init(c[h]);
    const int g_hi = (t0 + 15) >> 5;
#pragma unroll 1
    for (int g = cur * 8; g <= g_hi; ++g) { const int key0 = 32 * g;
        const bf16x8 a0 = ld8(KRm + (size_t)(key0 + col) * 32 + quad * 8), a1 = ld8(KRm + (size_t)(key0 + 16 + col) * 32 + quad * 8);
        const bf16x8 v0 = ld8(VFm + (size_t)g * 1024 + lane * 8), v1 = ld8(VFm + (size_t)g * 1024 + 512 + lane * 8);
        const int dist0 = tq - (key0 + 4 * quad);
#pragma unroll
        for (int h = 0; h < 4; ++h) { f32x4 z0, z1; scores2<1, 1>(a0, a1, qf[h], SL[h], dist0, z0, z1); col_update(c[h], z0, z1, v0, v1, lane); __builtin_amdgcn_sched_barrier(0); }
    }
    const LAS float* Gt = (const LAS float*)(wl + AW_G);
#pragma unroll
    for (int h = 0; h < 4; ++h) { const LAS float* gp = Gt + (col * 4 + h) * 36;
        col_merge(c[h], gp[0], gp[1], *(const LAS f32x4*)(gp + 4 + 4 * quad), *(const LAS f32x4*)(gp + 4 + 16 + 4 * quad), quad);
        const float f = 1.0f / quadall_sum(c[h].l, lane);
        const f32x4 x0 = c[h].o0 * f, x1 = c[h].o1 * f;
        gb op = OMB + (size_t)(b * SEQ + tq) * 128 + h * 32 + 4 * quad;
        u32x2 w0, w1; w0.x = cvtpk(x0[0], x0[1]); w0.y = cvtpk(x0[2], x0[3]); w1.x = cvtpk(x1[0], x1[1]); w1.y = cvtpk(x1[2], x1[3]);
        *(GAS u32x2*)op = w0; *(GAS u32x2*)(op + 16) = w1; }
}

__device__ __forceinline__ void sb_item2(unsigned char* ws_, int item, int lane) {
    GAS unsigned char* ws = (GAS unsigned char*)ws_;
    gcb QKV = (gcb)(ws + WS_QKV); gb OSB = (gb)(ws + WS_OCAT);
    const int b = item >> 12, h = (item >> 10) & 3, tg = item & 1023, t0 = tg * 16;
    const int col = lane & 15, quad = lane >> 4, tq = t0 + col;
    gcb KRh = (gcb)(ws + WS_KR) + (size_t)(3 + h) * KRV_BR + (size_t)b * SEQ * 32; gcb VFh = (gcb)(ws + WS_VF) + (size_t)(3 + h) * KRV_BR + (size_t)b * SEQ * 32;
    const bf16x8 qf = ld8(QKV + (size_t)(b * SEQ + tq) * 1024 + C_SBQ + h * 32 + quad * 8);
    f32x4 o0 = {0.f, 0.f, 0.f, 0.f}, o1 = o0; float carry = 0.f;
#pragma unroll 1
    for (int g = (t0 + 15) >> 5; g >= 0; --g) { const int key0 = 32 * g;
        const bf16x8 a0 = ld8(KRh + (size_t)(key0 + col) * 32 + quad * 8), a1 = ld8(KRh + (size_t)(key0 + 16 + col) * 32 + quad * 8);
        const bf16x8 v0 = ld8(VFh + (size_t)g * 1024 + lane * 8), v1 = ld8(VFh + (size_t)g * 1024 + 512 + lane * 8);
        const f32x4 zero = {0.f, 0.f, 0.f, 0.f};
        const f32x4 s0 = MFMA16(a0, qf, zero), s1 = MFMA16(a1, qf, zero);
        const int dist0 = tq - (key0 + 4 * quad);
        f32x4 z0, z1, ls0, ls1;
#pragma unroll
        for (int r = 0; r < 4; ++r) {
            const float x0 = s0[r] * ZC, x1 = s1[r] * ZC;
            const float sp0 = fmaxf(x0, 0.f) + lg2(1.0f + ex2(-fabsf(x0))), sp1 = fmaxf(x1, 0.f) + lg2(1.0f + ex2(-fabsf(x1)));
            const bool v0p = dist0 - r > 0, v1p = dist0 - 16 - r > 0;
            z0[r] = v0p ? x0 - sp0 : -INFINITY; z1[r] = v1p ? x1 - sp1 : -INFINITY; ls0[r] = v0p ? -sp0 : 0.f; ls1[r] = v1p ? -sp1 : 0.f; }
        const float G0 = (ls0[0] + ls0[1]) + (ls0[2] + ls0[3]), G1 = (ls1[0] + ls1[1]) + (ls1[2] + ls1[3]);
        const float a10 = shx(G0, 16, lane), a20 = shx(G0, 32, lane), a30 = shx(a10, 32, lane);
        const float a11 = shx(G1, 16, lane), a21 = shx(G1, 32, lane), a31 = shx(a11, 32, lane);
        const float hi0 = ((quad ^ 1) > quad ? a10 : 0.f) + ((quad ^ 2) > quad ? a20 : 0.f) + ((quad ^ 3) > quad ? a30 : 0.f);
        const float hi1 = ((quad ^ 1) > quad ? a11 : 0.f) + ((quad ^ 2) > quad ? a21 : 0.f) + ((quad ^ 3) > quad ? a31 : 0.f);
        const float tot0 = (G0 + a10) + (a20 + a30), tot1 = (G1 + a11) + (a21 + a31);
        const float e1 = carry + hi1, e0 = carry + tot1 + hi0;
        f32x4 p0, p1;
        p1[3] = ex2(z1[3] + e1); p1[2] = ex2(z1[2] + e1 + ls1[3]); p1[1] = ex2(z1[1] + e1 + (ls1[3] + ls1[2])); p1[0] = ex2(z1[0] + e1 + ((ls1[3] + ls1[2]) + ls1[1]));
        p0[3] = ex2(z0[3] + e0); p0[2] = ex2(z0[2] + e0 + ls0[3]); p0[1] = ex2(z0[1] + e0 + (ls0[3] + ls0[2])); p0[0] = ex2(z0[0] + e0 + ((ls0[3] + ls0[2]) + ls0[1]));
        carry += tot0 + tot1;
        const bf16x8 pb = pack_p(p0, p1);
        o0 = MFMA16(v0, pb, o0); o1 = MFMA16(v1, pb, o1);
        if (__all(carry < -151.0f)) break;
    }
    gb op = OSB + (size_t)(b * SEQ + tq) * 128 + h * 32 + 4 * quad;
    u32x2 w0, w1; w0.x = cvtpk(o0[0], o0[1]); w0.y = cvtpk(o0[2], o0[3]); w1.x = cvtpk(o1[0], o1[1]); w1.y = cvtpk(o1[2], o1[3]);
    *(GAS u32x2*)op = w0; *(GAS u32x2*)(op + 16) = w1;
}

__device__ __forceinline__ void attn_phase2(unsigned char* ws_, LAS unsigned char* lds, int vcu, int wave) {
    unsigned char* ws = opq_ptr(ws_);
    const int lane = lane_id();
    LAS unsigned char* wl = lds + RING_OFF + wave * AW_BYTES;
#ifdef NSA_SIMPLE
    { const int k = vcu * 4 + (wave & 3); if (wave < 4) nsa_item(ws, 0, k, lane); else nsa_item(ws, 1, 1023 - k, lane); }
#elif !defined(NO_NSA2)
    { const int k = vcu * 4 + (wave & 3); nsa_item2(ws, wl, wave < 4 ? 0 : 1, wave < 4 ? k : 1023 - k, lane); }
#endif
#ifdef MOBA_SIMPLE
    { const int it = vcu * 8 + wave; moba_item(ws, it >> 10, it & 1023, lane); }
#elif !defined(NO_MOBA2)
    { const int it = vcu * 8 + wave; moba_item2(ws, wl, it >> 10, it & 1023, lane); }
#endif
#ifdef SB_SIMPLE
    sb_item(ws, vcu * 8 + wave, lane);
#elif !defined(NO_SB2)
#pragma unroll 1
    for (int k = 0; k < 4; ++k) sb_item2(ws, (vcu * 8 + wave) + 2048 * k, lane);
#endif
}

__device__ __forceinline__ void ln_row(const float* y16, const float* g, const float* bta, int lane, float* o16) {
    float s = 0.f;
#pragma unroll
    for (int i = 0; i < 16; ++i) s += y16[i];
    const float mean = wave_sum(s, lane) * (1.0f / D); float s2 = 0.f;
#pragma unroll
    for (int i = 0; i < 16; ++i) { const float dd = y16[i] - mean; s2 = fmaf(dd, dd, s2); }
    const float rstd = 1.0f / sqrtf(wave_sum(s2, lane) * (1.0f / D) + LN_EPS);
#pragma unroll
    for (int hh = 0; hh < 2; ++hh)
#pragma unroll
        for (int i = 0; i < 8; ++i) { const int c = hh * 512 + lane * 8 + i; o16[hh * 8 + i] = (y16[hh * 8 + i] - mean) * rstd * g[c] + bta[c]; }
}
__device__ __forceinline__ void load_row16(const float* row, int lane, float* v) {
#pragma unroll
    for (int hh = 0; hh < 2; ++hh) { const f32x4 a = *(const f32x4*)(row + hh * 512 + lane * 8), b = *(const f32x4*)(row + hh * 512 + lane * 8 + 4);
        v[hh * 8 + 0] = a.x; v[hh * 8 + 1] = a.y; v[hh * 8 + 2] = a.z; v[hh * 8 + 3] = a.w; v[hh * 8 + 4] = b.x; v[hh * 8 + 5] = b.y; v[hh * 8 + 6] = b.z; v[hh * 8 + 7] = b.w; }
}
__device__ __forceinline__ void store_row16(float* row, bf16* rowb, int lane, const float* v) {
#pragma unroll
    for (int hh = 0; hh < 2; ++hh) {
        *(f32x4*)(row + hh * 512 + lane * 8) = (f32x4){v[hh * 8], v[hh * 8 + 1], v[hh * 8 + 2], v[hh * 8 + 3]};
        *(f32x4*)(row + hh * 512 + lane * 8 + 4) = (f32x4){v[hh * 8 + 4], v[hh * 8 + 5], v[hh * 8 + 6], v[hh * 8 + 7]};
        if (rowb) { v4u w; w.x = pk2(v[hh * 8], v[hh * 8 + 1]); w.y = pk2(v[hh * 8 + 2], v[hh * 8 + 3]); w.z = pk2(v[hh * 8 + 4], v[hh * 8 + 5]); w.w = pk2(v[hh * 8 + 6], v[hh * 8 + 7]);
            *(v4u*)(rowb + hh * 512 + lane * 8) = w; }
    }
}
__device__ __forceinline__ void ln1_phase(const Ptrs& A, int l, int vcu, int NGW, int wave) {
    const int lane = lane_id(), gw = vcu * NWAVES + wave;
    unsigned char* ws = opq_ptr(A.ws); const float* Y = (const float*)(ws + WS_Y); float* X1 = (float*)(ws + WS_X1); bf16* X1B = (bf16*)(ws + WS_XB);
    const float* g = A.in[10] + (size_t)l * D; const float* bt = A.in[11] + (size_t)l * D;
    for (int m = gw; m < M; m += NGW) { float y[16], o[16]; load_row16(Y + (size_t)m * D, lane, y); ln_row(y, g, bt, lane, o); store_row16(X1 + (size_t)m * D, X1B + (size_t)m * D, lane, o); }
}

__device__ __forceinline__ float gelu_tanh(float x) {
    const float u = 0.7978845608028654f * (x + 0.044715f * x * x * x);
    const float e = __expf(-2.0f * fabsf(u)); const float th = (1.0f - e) / (1.0f + e);
    return 0.5f * x * (1.0f + (u < 0.f ? -th : th));
}
__device__ __forceinline__ void peer_wave(const Ptrs& A, int l, int vcu, bool last, int wave) {
    const int lane = lane_id(), tok0 = (vcu * NWAVES + wave) * 16;
    unsigned char* ws = opq_ptr(A.ws);
    const bf16* QP = (const bf16*)(ws + WS_QP); const bf16* PK = (const bf16*)(ws + WS_PK) + (size_t)l * 4 * 2 * 16384;
    const bf16* UT = (const bf16*)(ws + WS_UT) + (size_t)l * NEXP * D; const bf16* VT = (const bf16*)(ws + WS_VT) + (size_t)l * NEXP * D;
    const float* X1 = (const float*)(ws + WS_X1);
    float* Xout = last ? A.out : (float*)(ws + WS_X); bf16* XBout = last ? nullptr : (bf16*)(ws + WS_XB);
    const int col = lane & 15, qd = lane >> 4;
    float mytop[8]; int myidx[8];
#pragma unroll
    for (int i = 0; i < 8; ++i) { mytop[i] = 0.f; myidx[i] = 0; }
#pragma unroll 1
    for (int h = 0; h < 4; ++h) {
        float v12[2][8]; int i12[2][8];
#pragma unroll
        for (int half = 0; half < 2; ++half) {
            f32x4 sc[8];
#pragma unroll
            for (int kt = 0; kt < 8; ++kt) sc[kt] = (f32x4){0.f, 0.f, 0.f, 0.f};
            const bf16* kp = PK + (size_t)(h * 2 + half) * 16384 + (size_t)col * 128 + qd * 8;
            const bf16* qp = QP + (size_t)(tok0 + col) * 1024 + h * 256 + half * 128 + qd * 8;
#pragma unroll
            for (int ks = 0; ks < 4; ++ks) { const bf16x8 bq = __builtin_bit_cast(bf16x8, *(const v4u*)(qp + ks * 32));
#pragma unroll
                for (int kt = 0; kt < 8; ++kt) { const bf16x8 ak = __builtin_bit_cast(bf16x8, *(const v4u*)(kp + (size_t)kt * 16 * 128 + ks * 32));
                    sc[kt] = __builtin_amdgcn_mfma_f32_16x16x32_bf16(ak, bq, sc[kt], 0, 0, 0); } }
#pragma unroll
            for (int r8 = 0; r8 < 8; ++r8) {
                float best = -INFINITY; int bi = 0x7fffffff;
#pragma unroll
                for (int kt = 0; kt < 8; ++kt)
#pragma unroll
                    for (int rr = 0; rr < 4; ++rr) { const float v = sc[kt][rr]; const bool tk = v > best; best = tk ? v : best; bi = tk ? (kt * 16 + 4 * qd + rr) : bi; }
#pragma unroll
                for (int off = 16; off <= 32; off <<= 1) { const float ov = shx(best, off, lane); const int oi = shxi(bi, off, lane);
                    const bool tk = (ov > best) || (ov == best && oi < bi); best = tk ? ov : best; bi = tk ? oi : bi; }
                v12[half][r8] = best; i12[half][r8] = bi;
#pragma unroll
                for (int kt = 0; kt < 8; ++kt)
#pragma unroll
                    for (int rr = 0; rr < 4; ++rr) sc[kt][rr] = ((kt * 16 + 4 * qd + rr) == bi) ? -INFINITY : sc[kt][rr];
            }
        }
        float cv[20]; int ce[20];
        {
            constexpr int A20[20] = {0, 0, 0, 0, 0, 0, 0, 0, 1, 1, 1, 1, 2, 2, 3, 3, 4, 5, 6, 7}, B20[20] = {0, 1, 2, 3, 4, 5, 6, 7, 0, 1, 2, 3, 0, 1, 0, 1, 0, 0, 0, 0};
#pragma unroll
            for (int e = 0; e < 20; ++e) { cv[e] = v12[0][A20[e]] + v12[1][B20[e]]; ce[e] = i12[0][A20[e]] * 128 + i12[1][B20[e]]; }
        }
#pragma unroll
        for (int r8 = 0; r8 < 8; ++r8) {
            float best = -INFINITY; int be = 0, bx = -1;
#pragma unroll
            for (int e = 0; e < 20; ++e) { const bool tk = cv[e] > best; best = tk ? cv[e] : best; be = tk ? ce[e] : be; bx = tk ? e : bx; }
#pragma unroll
            for (int e = 0; e < 20; ++e) cv[e] = (e == bx) ? -INFINITY : cv[e];
            if (qd == h) { mytop[r8] = best; myidx[r8] = be; }
        }
    }
    float myg[8];
    { float s = 0.f;
#pragma unroll
      for (int i = 0; i < 8; ++i) { myg[i] = __expf(mytop[i] - mytop[0]); s += myg[i]; }
      const float is = 1.0f / s;
#pragma unroll
      for (int i = 0; i < 8; ++i) myg[i] *= is; }
    const float* g2 = A.in[17] + (size_t)l * D; const float* b2 = A.in[18] + (size_t)l * D;
#pragma unroll 1
    for (int tt = 0; tt < 16; ++tt) {
        const int tok = tok0 + tt;
        float xr[16], outv[16];
        load_row16(X1 + (size_t)tok * D, lane, xr);
#pragma unroll
        for (int i = 0; i < 16; ++i) outv[i] = 0.f;
#pragma unroll 1
        for (int h = 0; h < 4; ++h) {
            const int src = tt + 16 * h; float dp[8]; int ex[8];
#pragma unroll
            for (int e = 0; e < 8; ++e) {
                ex[e] = __builtin_amdgcn_readlane(myidx[e], src);
                const bf16* ur = UT + (size_t)ex[e] * D;
                const v4u a = *(const v4u*)(ur + lane * 8), c = *(const v4u*)(ur + 512 + lane * 8);
                float f[16]; unpack8(a, f); unpack8(c, f + 8);
                float s = 0.f;
#pragma unroll
                for (int i = 0; i < 16; ++i) s = fmaf(f[i], xr[i], s);
                dp[e] = s;
            }
#pragma unroll
            for (int e = 0; e < 8; ++e) dp[e] = wave_sum(dp[e], lane);
#pragma unroll
            for (int e = 0; e < 8; ++e) {
                const float gg = __int_as_float(__builtin_amdgcn_readlane(__float_as_int(myg[e]), src));
                const float w = gg * gelu_tanh(dp[e]);
                const bf16* vr = VT + (size_t)ex[e] * D;
                const v4u a = *(const v4u*)(vr + lane * 8), c = *(const v4u*)(vr + 512 + lane * 8);
                float f[16]; unpack8(a, f); unpack8(c, f + 8);
#pragma unroll
                for (int i = 0; i < 16; ++i) outv[i] = fmaf(w, f[i], outv[i]);
            }
        }
        float y[16], o[16];
#pragma unroll
        for (int i = 0; i < 16; ++i) y[i] = fmaf(ALPHA, xr[i], outv[i]);
        ln_row(y, g2, b2, lane, o);
        store_row16(Xout + (size_t)tok * D, XBout ? XBout + (size_t)tok * D : nullptr, lane, o);
    }
}

#ifndef REP_ATTN
#define REP_ATTN 1
#endif
#ifndef REP_PEER
#define REP_PEER 1
#endif
#ifndef REP_GEMM
#define REP_GEMM 1
#endif
__global__ void __launch_bounds__(NWAVES * 64, 2) hybrid_fwd(Ptrs A) {
    extern __shared__ __attribute__((aligned(16))) unsigned char lds_raw[];
    LAS unsigned char* lds = (LAS unsigned char*)lds_raw;
    volatile LAS unsigned* MISC = (volatile LAS unsigned*)(lds + MISC_OFF);
    const int G = gridDim.x, bx = blockIdx.x, vcu = (G % 8 == 0) ? (bx % 8) * (G / 8) + bx / 8 : bx, NGW = G * NWAVES;
    const int wave = __builtin_amdgcn_readfirstlane(threadIdx.x >> 6);
#define LEADER() (opq(wave) == 0 && lane_id() == 0)
    for (int u = wave * 64 + lane_id(); u < (LDS_BYTES - LDSCTL_OFF) / 4; u += NWAVES * 64) ((LAS unsigned*)(lds + LDSCTL_OFF))[u] = 0u;
    __syncthreads();
    XcdBarrier bar = xcd_barrier_post((unsigned*)(A.ws + WS_CTL) + CW_BAR, MISC + 8, LEADER());

#ifndef NO_PRO
    prologue(A, lds, opq(vcu), NGW, opq(wave));
#endif
    xcd_barrier(bar, LEADER());

#pragma unroll 1
    for (int l = 0; l < DEPTH; ++l) {
#ifndef NO_G1
        _Pragma("unroll 1") for (int rep = 0; rep < REP_GEMM; ++rep)
        { unsigned char* ws = opq_ptr(A.ws); const pg8::bf16_t* XB = (const pg8::bf16_t*)(ws + WS_XB);
          pg8::Gemm g{XB, (const pg8::bf16_t*)(ws + WS_WQKV) + (size_t)l * 1024 * 1024, M, 1024, D}; pg8::StaticOrder S; S.init(M, 1024, opq(G), opq(bx));
          pg8::EpiBf16<0> E{(pg8::bf16_t*)(ws + WS_QKV), 1024, nullptr, 0, 0, 1.f};
          pg8::gemm_phase<pg8::EpiBf16<0>, pg8::StaticOrder, true, true>(lds + RING_OFF, g, S, E, opq(wave)); }
#endif
        xcd_barrier(bar, LEADER());
#if defined(NSA_SIMPLE) || defined(MOBA_SIMPLE) || defined(SB_SIMPLE)
        prep_phase(A, l, opq(vcu), NGW, opq(wave));
#endif
        prep2_phase(A, l, opq(vcu), NGW, opq(wave));
        xcd_barrier(bar, LEADER());
#ifndef NO_ATTN
        _Pragma("unroll 1") for (int rep = 0; rep < REP_ATTN; ++rep)
        if (opq(G) == 256) attn_phase2(A.ws, lds, opq(vcu), opq(wave));
#endif
        xcd_barrier(bar, LEADER());
#ifndef NO_G2
        _Pragma("unroll 1") for (int rep = 0; rep < REP_GEMM; ++rep)
        { unsigned char* ws = opq_ptr(A.ws);
          pg8::Gemm g{(const pg8::bf16_t*)(ws + WS_OCAT), (const pg8::bf16_t*)(ws + WS_WBR) + (size_t)l * 3 * 1024 * 128, 3 * M, 3 * 1024, 128}; pg8::BranchOrder S{opq(G), opq(bx)};
          pg8::EpiBranch E{(pg8::bf16_t*)(ws + WS_P)};
          pg8::gemm_phase<pg8::EpiBranch, pg8::BranchOrder, true, true>(lds + RING_OFF, g, S, E, opq(wave)); }
#endif
        xcd_barrier(bar, LEADER());
#ifndef NO_G3
        _Pragma("unroll 1") for (int rep = 0; rep < REP_GEMM; ++rep)
        { unsigned char* ws = opq_ptr(A.ws); const pg8::bf16_t* XB = (const pg8::bf16_t*)(ws + WS_XB);
          pg8::Gemm g{XB, (const pg8::bf16_t*)(ws + WS_WGATE) + (size_t)l * 3072 * 1024, M, 3072, D}; pg8::GateOrder S; S.so.init(M, 1024, opq(G), opq(bx));
          pg8::EpiMerge E{(const pg8::bf16_t*)(ws + WS_P), (pg8::bf16_t*)(ws + WS_QKV), M};
          pg8::gemm_phase<pg8::EpiMerge, pg8::GateOrder, true, true>(lds + RING_OFF, g, S, E, opq(wave)); }
#endif
        xcd_barrier(bar, LEADER());
#ifndef NO_G4
        _Pragma("unroll 1") for (int rep = 0; rep < REP_GEMM; ++rep)
        { unsigned char* ws = opq_ptr(A.ws); const float* xin = (l == 0) ? A.in[0] : (const float*)(ws + WS_X);
          pg8::Gemm g{(const pg8::bf16_t*)(ws + WS_QKV), (const pg8::bf16_t*)(ws + WS_WOUT) + (size_t)l * 1024 * 1024, M, 1024, D}; pg8::StaticOrder S; S.init(M, 1024, opq(G), opq(bx));
          pg8::EpiResF32 E{xin, (float*)(ws + WS_Y), D, ALPHA};
          pg8::gemm_phase<pg8::EpiResF32, pg8::StaticOrder, true, true>(lds + RING_OFF, g, S, E, opq(wave)); }
#endif
        xcd_barrier(bar, LEADER());
#ifndef NO_LN1
        ln1_phase(A, l, opq(vcu), NGW, opq(wave));
#endif
        xcd_barrier(bar, LEADER());
#ifndef NO_G5
        _Pragma("unroll 1") for (int rep = 0; rep < REP_GEMM; ++rep)
        { unsigned char* ws = opq_ptr(A.ws); const pg8::bf16_t* XB = (const pg8::bf16_t*)(ws + WS_XB);
          pg8::Gemm g{XB, (const pg8::bf16_t*)(ws + WS_WQ) + (size_t)l * 1024 * 1024, M, 1024, D}; pg8::StaticOrder S; S.init(M, 1024, opq(G), opq(bx));
          pg8::EpiBf16<0> E{(pg8::bf16_t*)(ws + WS_QP), 1024, nullptr, 0, 0, 1.f};
          pg8::gemm_phase<pg8::EpiBf16<0>, pg8::StaticOrder, true, true>(lds + RING_OFF, g, S, E, opq(wave)); }
#endif
        xcd_barrier(bar, LEADER());
#ifndef NO_PEER
        _Pragma("unroll 1") for (int rep = 0; rep < REP_PEER; ++rep)
        if (opq(G) == 256) peer_wave(A, l, opq(vcu), l == DEPTH - 1, opq(wave));
#endif
        if (l != DEPTH - 1) xcd_barrier(bar, LEADER());
    }
}

extern "C" void kernel_launch(void* const* d_in, const int* in_sizes, int n_in, void* d_out, int out_size, void* d_ws, size_t ws_size, hipStream_t stream) {
    static int grid = 0;
    if (grid == 0) {
        if (n_in != 19 || out_size != M * D || ws_size < WS_END2) { fprintf(stderr, "kernel_launch: unexpected shapes (n_in %d, out %d, ws %zu); nothing launched\n", n_in, out_size, ws_size); grid = -1; return; }
        int dev = 0, cus = 0, per_cu = 0;
        if (hipGetDevice(&dev) != hipSuccess || hipDeviceGetAttribute(&cus, hipDeviceAttributeMultiprocessorCount, dev) != hipSuccess) { grid = -1; return; }
        if (hipFuncSetAttribute((const void*)hybrid_fwd, hipFuncAttributeMaxDynamicSharedMemorySize, LDS_BYTES) != hipSuccess) { fprintf(stderr, "kernel_launch: hipFuncSetAttribute failed\n"); grid = -1; return; }
        if (hipOccupancyMaxActiveBlocksPerMultiprocessor(&per_cu, (const void*)hybrid_fwd, NWAVES * 64, LDS_BYTES) != hipSuccess || per_cu < 1)
            fprintf(stderr, "kernel_launch: note: occupancy query reports %d workgroups per CU\n", per_cu);
        (void)hipGetLastError();
        grid = cus;
    }
    if (grid < 0) return;
    if (hipMemsetAsync((char*)d_ws + WS_CTL, 0, CTL_ZERO_BYTES, stream) != hipSuccess) return;
    Ptrs a{};
    for (int i = 0; i < 19; ++i) a.in[i] = (const float*)d_in[i];
    a.out = (float*)d_out; a.ws = (unsigned char*)d_ws;
    hipLaunchKernelGGL(hybrid_fwd, dim3(grid), dim3(NWAVES * 64), LDS_BYTES, stream, a);
}
```

```cpp
#include <hip/hip_runtime.h>
#include <cstdio>
#include <cstdint>
#include <cmath>
namespace pg8 {
#define PG8_LAS __attribute__((address_space(3)))
typedef unsigned short bf16_t;
typedef short bf16x8 __attribute__((ext_vector_type(8)));
typedef float f32x4 __attribute__((ext_vector_type(4)));
typedef unsigned u32x4 __attribute__((ext_vector_type(4)));
constexpr int BM = 256, BK = 64, HALF = 128, HTB = HALF * BK * 2  , STAGE_BYTES = 8 * HTB, NXCD = 8, WGM = 8;

__host__ __device__ __forceinline__ int lds_byte(int r, int c) { const int st = (r >> 4) * 2 + (c >> 5), rr = r & 15, cc = c & 31, ob = rr * 64 + cc * 2; return st * 1024 + (ob ^ (((ob >> 9) & 1) << 5)); }
__host__ __device__ __forceinline__ void stage_rc(int b, int& R, int& C) { const int st = b / 1024, sb = b % 1024, swz = sb ^ (((sb >> 9) & 1) << 5); R = (st >> 1) * 16 + swz / 64; C = (st & 1) * 32 + (swz % 64) / 2; }
__host__ __device__ __forceinline__ int perm32(int rho) { const int n = rho >> 4, i = rho & 15; return 8 * (i >> 2) + 4 * n + (i & 3); }

struct Unit { int pm, pn; };
struct Gemm { const bf16_t* A; const bf16_t* Bt; int M, N, K; };

struct StaticOrder {
    int nM, nN, nwg, G, c;
    __host__ __device__ void init(int M, int N, int G_, int c_) { nM = M / BM; nN = N / BM; nwg = nM * nN; G = G_; c = c_; }
    __host__ __device__ bool next(int i, Unit& u) const {
        const long L = (long)i * G + c; if (L >= nwg) return false;
        int wgid = (int)L; { const int q = nwg / NXCD, r = nwg % NXCD, xcd = wgid % NXCD, off = wgid / NXCD; wgid = (xcd < r ? xcd * (q + 1) : r * (q + 1) + (xcd - r) * q) + off; }
        const int nig = WGM * nN, gid = wgid / nig, fm = gid * WGM, gsz = (nM - fm) < WGM ? (nM - fm) : WGM;
        u.pm = fm + ((wgid % nig) % gsz); u.pn = (wgid % nig) / gsz; return true;
    }
    __device__ __forceinline__ void a_ready(const Unit&) const {}
    __device__ __forceinline__ void done(const Unit&) const {}
};

__device__ __forceinline__ unsigned cvt_pk_bf16(float lo, float hi) { unsigned r; asm volatile("v_cvt_pk_bf16_f32 %0, %1, %2" : "=v"(r) : "v"(lo), "v"(hi)); return r; }
typedef float f32x2 __attribute__((ext_vector_type(2)));
__device__ __forceinline__ f32x2 gelu_pk(f32x2 v) {
    const f32x2 av = __builtin_elementwise_abs(v), d = av * 0.2316418882f + 1.0f;
    f32x2 t; t.x = __builtin_amdgcn_rcpf(d.x); t.y = __builtin_amdgcn_rcpf(d.y);
    f32x2 q = t * 0.5307027145f + (-0.7265760135f); q = q * t + 0.7107068705f; q = q * t + (-0.142248368f); q = q * t + 0.127414796f; q = q * t;
    const f32x2 s = (v * v) * (-0.72134752044f);
    f32x2 e; e.x = __builtin_amdgcn_exp2f(s.x); e.y = __builtin_amdgcn_exp2f(s.y);
    const f32x2 m = v * (q * e), r = v - m;
    f32x2 o; o.x = v.x < 0.f ? m.x : r.x; o.y = v.y < 0.f ? m.y : r.y; return o;
}

template <int ACT  > struct EpiBf16 {
    static constexpr bool PERM = true, AFTER_DRAIN = false; static_assert(ACT == 0 || ACT == 1, "EpiBf16: ACT is 0 (none) or 1 (gelu_pk)");
    bf16_t* O; int ldc; const float* bias; int split_cols; size_t split_stride; float scale0;
    __device__ __forceinline__ void operator()(const f32x4 (&acc)[2][2][4][2], const Unit& u, int wr, int wc, int fr, int fq) const {
        const int row0 = u.pm * BM + wr * 64 + fr; int colt = u.pn * BM; bf16_t* base = O;
        float sc = 1.f; if (split_cols) { const int t = colt / split_cols; base += (size_t)t * split_stride; colt -= t * split_cols; if (t == 0) sc = scale0; }
        const int col0 = colt + wc * 32 + 8 * fq, bcol0 = u.pn * BM + wc * 32 + 8 * fq;
        f32x4 bv[2][2];
#pragma unroll
        for (int bj = 0; bj < 2; ++bj)
#pragma unroll
            for (int n = 0; n < 2; ++n) bv[bj][n] = bias ? *(const f32x4*)(bias + bcol0 + bj * HALF + 4 * n) : (f32x4){0.f, 0.f, 0.f, 0.f};
#pragma unroll
        for (int ai = 0; ai < 2; ++ai)
#pragma unroll
            for (int m = 0; m < 4; ++m) { bf16_t* rowp = base + (size_t)(row0 + ai * HALF + m * 16) * ldc + col0;
#pragma unroll
                for (int bj = 0; bj < 2; ++bj) { f32x4 v0 = acc[ai][bj][m][0] + bv[bj][0], v1 = acc[ai][bj][m][1] + bv[bj][1];
                    if (ACT == 1) { f32x2 a = gelu_pk((f32x2){v0[0], v0[1]}), b = gelu_pk((f32x2){v0[2], v0[3]}), c = gelu_pk((f32x2){v1[0], v1[1]}), d = gelu_pk((f32x2){v1[2], v1[3]});
                        v0 = (f32x4){a.x, a.y, b.x, b.y}; v1 = (f32x4){c.x, c.y, d.x, d.y}; }
                    v0 = v0 * sc; v1 = v1 * sc; u32x4 w; w.x = cvt_pk_bf16(v0[0], v0[1]); w.y = cvt_pk_bf16(v0[2], v0[3]); w.z = cvt_pk_bf16(v1[0], v1[1]); w.w = cvt_pk_bf16(v1[2], v1[3]);
                    *(u32x4*)(rowp + bj * HALF) = w; } }
    }
};
template <class Epi, class Sched, bool ALIGN_EPI = false, bool SP2 = false>
__device__ __forceinline__ void gemm_phase(PG8_LAS unsigned char* lds, const Gemm g, const Sched& S, const Epi& E, const int wid) {
    int lane_o; asm volatile("v_mbcnt_lo_u32_b32 %0, -1, 0\n\tv_mbcnt_hi_u32_b32 %0, -1, %0" : "=v"(lane_o));
    const int lane = lane_o, tid = wid * 64 + lane, wr = wid >> 2, wc = wid & 3, fr = lane & 15, fq = lane >> 4;
    const int K = g.K, nt = K / BK;
    unsigned voffA[2], voffB[2];
#pragma unroll
    for (int i = 0; i < 2; ++i) { int R, C; stage_rc(tid * 16 + i * 8192, R, C); const int Rb = Epi::PERM ? ((R & ~31) + perm32(R & 31)) : R;
        voffA[i] = (unsigned)(R * K + C) * 2u; voffB[i] = (unsigned)(Rb * K + C) * 2u; }
    const size_t kstep = (size_t)(BK * 2);
    const size_t hstep = (size_t)HALF * K * 2;
    const size_t tstep = 2 * hstep;
    const unsigned ldsw = (unsigned)wid * 1024u;
    const int aoff = lds_byte(wr * 64 + fr, fq * 8), boff = lds_byte(wc * 32 + fr, fq * 8);
#define PG8_SA(b, h) (((b) * 2 + (h)) * HTB)
#define PG8_SB(b, h) ((4 + (b) * 2 + (h)) * HTB)
#define PG8_STAGE(bufoff, gbase, voff) do { _Pragma("unroll") for (int _i = 0; _i < 2; ++_i) \
        __builtin_amdgcn_global_load_lds((const unsigned*)((const char*)(gbase) + (voff)[_i]), (PG8_LAS unsigned*)(lds + (bufoff) + ldsw + _i * 8192), 16, 0, 0); } while (0)
#define PG8_LDA(dst, b, h) do { _Pragma("unroll") for (int m = 0; m < 4; ++m) _Pragma("unroll") for (int k = 0; k < 2; ++k) dst[m][k] = *(const PG8_LAS bf16x8*)(lds + PG8_SA(b, h) + aoff + m * 2048 + k * 1024); } while (0)
#define PG8_LDB(dst, b, h) do { _Pragma("unroll") for (int n = 0; n < 2; ++n) _Pragma("unroll") for (int k = 0; k < 2; ++k) dst[n][k] = *(const PG8_LAS bf16x8*)(lds + PG8_SB(b, h) + boff + n * 2048 + k * 1024); } while (0)
#define PG8_MMA(ai, bj, At, Bt) do { __builtin_amdgcn_s_setprio(1); _Pragma("unroll") for (int m = 0; m < 4; ++m) _Pragma("unroll") for (int n = 0; n < 2; ++n) _Pragma("unroll") for (int k = 0; k < 2; ++k) \
        acc[ai][bj][m][n] = __builtin_amdgcn_mfma_f32_16x16x32_bf16(Bt[n][k], At[m][k], acc[ai][bj][m][n], 0, 0, 0); __builtin_amdgcn_s_setprio(0); } while (0)
#define PG8_WAIT_V(n) asm volatile("s_waitcnt vmcnt(" #n ")" ::: "memory")
#define PG8_WAIT_L(n) asm volatile("s_waitcnt lgkmcnt(" #n ")" ::: "memory")
#define PG8_BAR __builtin_amdgcn_s_barrier()
#define PG8_SCHED __builtin_amdgcn_sched_barrier(0)
    Unit cur, nxt; int ui = 0;
    if (!S.next(0, cur)) return;
    f32x4 acc[2][2][4][2];
#pragma unroll
    for (int a = 0; a < 2; ++a)
#pragma unroll
        for (int b = 0; b < 2; ++b)
#pragma unroll
            for (int m = 0; m < 4; ++m)
#pragma unroll
                for (int n = 0; n < 2; ++n) acc[a][b][m][n] = (f32x4){0.f, 0.f, 0.f, 0.f};
    bf16x8 At[4][2], B0[2][2], B1[2][2];
    const char* cA = (const char*)g.A + (size_t)cur.pm * tstep; const char* cB = (const char*)g.Bt + (size_t)cur.pn * tstep;
    S.a_ready(cur);
    if constexpr (SP2) {
        PG8_STAGE(PG8_SB(0, 0), cB, voffB); PG8_STAGE(PG8_SB(0, 1), cB + hstep, voffB); PG8_STAGE(PG8_SA(0, 0), cA, voffA); PG8_STAGE(PG8_SA(0, 1), cA + hstep, voffA);
        if (wr == 1) PG8_BAR;
        PG8_WAIT_V(2); PG8_BAR;
        PG8_STAGE(PG8_SB(1, 0), cB + kstep, voffB); PG8_STAGE(PG8_SA(1, 0), cA + kstep, voffA); PG8_STAGE(PG8_SB(1, 1), cB + hstep + kstep, voffB);
        PG8_WAIT_V(6); PG8_BAR;
    } else {
        PG8_STAGE(PG8_SB(0, 0), cB, voffB); PG8_STAGE(PG8_SA(0, 0), cA, voffA); PG8_STAGE(PG8_SB(0, 1), cB + hstep, voffB); PG8_STAGE(PG8_SA(0, 1), cA + hstep, voffA);
        if (wr == 1) PG8_BAR;
        PG8_WAIT_V(4); PG8_BAR;
        PG8_STAGE(PG8_SB(1, 0), cB + kstep, voffB); PG8_STAGE(PG8_SA(1, 0), cA + kstep, voffA); PG8_STAGE(PG8_SB(1, 1), cB + hstep + kstep, voffB);
        PG8_WAIT_V(6); PG8_BAR;
    }
    for (;;) {
        const bool has_next = S.next(ui + 1, nxt);
        const char* nA = has_next ? (const char*)g.A + (size_t)nxt.pm * tstep : cA; const char* nB = has_next ? (const char*)g.Bt + (size_t)nxt.pn * tstep : cB;
        for (int t = 0; t < nt; t += 2) {
            const bool last = (t == nt - 2);
            const char* a1 = cA + (size_t)(t + 1) * kstep;
            const char* a2 = last ? nA : cA + (size_t)(t + 2) * kstep; const char* b2 = last ? nB : cB + (size_t)(t + 2) * kstep;
            const char* a3 = a2 + kstep; const char* b3 = b2 + kstep;
            if (last && has_next) S.a_ready(nxt);
            if constexpr (SP2) {
            PG8_LDB(B0, 0, 0); PG8_LDB(B1, 0, 1); PG8_SCHED; PG8_LDA(At, 0, 0); PG8_STAGE(PG8_SA(1, 1), a1 + hstep, voffA);
            PG8_WAIT_V(8); PG8_WAIT_L(0); PG8_BAR; PG8_MMA(0, 0, At, B0); PG8_MMA(0, 1, At, B1); PG8_BAR; PG8_SCHED;
            PG8_LDA(At, 0, 1); PG8_STAGE(PG8_SB(0, 0), b2, voffB); PG8_STAGE(PG8_SB(0, 1), b2 + hstep, voffB); PG8_STAGE(PG8_SA(0, 0), a2, voffA);
            PG8_WAIT_V(8); PG8_WAIT_L(0); PG8_BAR; PG8_MMA(1, 0, At, B0); PG8_MMA(1, 1, At, B1); PG8_BAR; PG8_SCHED;
            PG8_LDB(B0, 1, 0); PG8_LDB(B1, 1, 1); PG8_SCHED; PG8_LDA(At, 1, 0); PG8_STAGE(PG8_SA(0, 1), a2 + hstep, voffA);
            PG8_WAIT_V(8); PG8_WAIT_L(0); PG8_BAR; PG8_MMA(0, 0, At, B0); PG8_MMA(0, 1, At, B1); PG8_BAR; PG8_SCHED;
            PG8_LDA(At, 1, 1); PG8_STAGE(PG8_SB(1, 0), b3, voffB); PG8_STAGE(PG8_SB(1, 1), b3 + hstep, voffB); PG8_STAGE(PG8_SA(1, 0), a3, voffA);
            PG8_WAIT_V(8); PG8_WAIT_L(0); PG8_BAR; PG8_MMA(1, 0, At, B0); PG8_MMA(1, 1, At, B1); PG8_BAR; PG8_SCHED;
            } else {
            PG8_LDB(B0, 0, 0); PG8_SCHED; PG8_LDA(At, 0, 0); PG8_STAGE(PG8_SA(1, 1), a1 + hstep, voffA);
            PG8_WAIT_L(8); PG8_BAR; PG8_WAIT_L(0); PG8_MMA(0, 0, At, B0); PG8_BAR; PG8_SCHED;
            PG8_LDB(B1, 0, 1); PG8_STAGE(PG8_SB(0, 0), b2, voffB);
            PG8_BAR; PG8_WAIT_L(0); PG8_MMA(0, 1, At, B1); PG8_BAR;
            PG8_LDA(At, 0, 1); PG8_STAGE(PG8_SA(0, 0), a2, voffA);
            PG8_BAR; PG8_WAIT_L(0); PG8_MMA(1, 0, At, B0); PG8_BAR; PG8_SCHED;
            PG8_STAGE(PG8_SB(0, 1), b2 + hstep, voffB);
            PG8_WAIT_V(6); PG8_BAR; PG8_MMA(1, 1, At, B1); PG8_BAR;
            PG8_LDB(B0, 1, 0); PG8_SCHED; PG8_LDA(At, 1, 0); PG8_STAGE(PG8_SA(0, 1), a2 + hstep, voffA);
            PG8_WAIT_L(8); PG8_BAR; PG8_WAIT_L(0); PG8_MMA(0, 0, At, B0); PG8_BAR; PG8_SCHED;
            PG8_LDB(B1, 1, 1); PG8_STAGE(PG8_SB(1, 0), b3, voffB);
            PG8_BAR; PG8_WAIT_L(0); PG8_MMA(0, 1, At, B1); PG8_BAR;
            PG8_LDA(At, 1, 1); PG8_STAGE(PG8_SA(1, 0), a3, voffA);
            PG8_BAR; PG8_WAIT_L(0); PG8_MMA(1, 0, At, B0); PG8_BAR; PG8_SCHED;
            PG8_STAGE(PG8_SB(1, 1), b3 + hstep, voffB);
            PG8_WAIT_V(6); PG8_BAR; PG8_MMA(1, 1, At, B1); PG8_BAR;
            }
        }
        if constexpr (ALIGN_EPI) { if (wr == 0) PG8_BAR; }
        if constexpr (!Epi::AFTER_DRAIN) { E(acc, cur, wr, wc, fr, fq); S.done(cur); }
        if (!has_next) break;
#pragma unroll
        for (int a = 0; a < 2; ++a)
#pragma unroll
            for (int b = 0; b < 2; ++b)
#pragma unroll
                for (int m = 0; m < 4; ++m)
#pragma unroll
                    for (int n = 0; n < 2; ++n) acc[a][b][m][n] = (f32x4){0.f, 0.f, 0.f, 0.f};
        cur = nxt; cA = nA; cB = nB; ++ui;
        if constexpr (ALIGN_EPI) { if (wr == 1) PG8_BAR; }
    }
    PG8_WAIT_V(0);
    if constexpr (!ALIGN_EPI) { if (wr == 0) PG8_BAR; }
    PG8_BAR;
    if constexpr (Epi::AFTER_DRAIN) { E.fused(acc, cur, wr, wc, fr, fq, lds, wid, lane); S.done(cur); }
#undef PG8_SA
#undef PG8_SB
#undef PG8_STAGE
#undef PG8_LDA
#undef PG8_LDB
#undef PG8_MMA
#undef PG8_WAIT_V
#undef PG8_WAIT_L
#undef PG8_BAR
#undef PG8_SCHED
}
}

namespace pg8 {
typedef unsigned u32x4e __attribute__((ext_vector_type(4)));
__device__ __forceinline__ float bf_lo(unsigned w) { return __uint_as_float(w << 16); }
__device__ __forceinline__ float bf_hi(unsigned w) { return __uint_as_float(w & 0xffff0000u); }
__device__ __forceinline__ float sigmoidf_(float x) { return __builtin_amdgcn_rcpf(1.0f + __expf(-x)); }

struct BranchOrder {
    int G, c;
    __device__ bool next(int i, Unit& u) const {
        const int L = i * G + c; if (L >= 1536) return false;
        const int b = L >> 9, r = L & 511; u.pm = b * 128 + (r >> 2); u.pn = b * 4 + (r & 3); return true;
    }
    __device__ __forceinline__ void a_ready(const Unit&) const {}
    __device__ __forceinline__ void done(const Unit&) const {}
};
struct GateOrder {
    StaticOrder so;
    __device__ bool next(int i, Unit& u) const {
        Unit t; if (!so.next(i / 3, t)) return false;
        u.pm = t.pm; u.pn = (i % 3) * 4 + t.pn; return true;
    }
    __device__ __forceinline__ void a_ready(const Unit&) const {}
    __device__ __forceinline__ void done(const Unit&) const {}
};
struct EpiMerge {
    static constexpr bool PERM = true, AFTER_DRAIN = false;
    const bf16_t* P; bf16_t* MIX; int Mrows;
    __device__ __forceinline__ void operator()(const f32x4 (&acc)[2][2][4][2], const Unit& u, int wr, int wc, int fr, int fq) const {
        const int b = u.pn >> 2, pc = u.pn & 3;
        const int row0 = u.pm * BM + wr * 64 + fr, col0 = pc * BM + wc * 32 + 8 * fq;
        const bf16_t* Pb = P + (size_t)b * Mrows * 1024;
#pragma unroll
        for (int ai = 0; ai < 2; ++ai)
#pragma unroll
            for (int m = 0; m < 4; ++m) { const size_t ro = (size_t)(row0 + ai * HALF + m * 16) * 1024 + col0;
#pragma unroll
                for (int bj = 0; bj < 2; ++bj) {
                    const f32x4 v0 = acc[ai][bj][m][0], v1 = acc[ai][bj][m][1];
                    const u32x4 pw = *(const u32x4*)(Pb + ro + bj * HALF);
                    float r[8];
                    r[0] = sigmoidf_(v0[0]) * bf_lo(pw.x); r[1] = sigmoidf_(v0[1]) * bf_hi(pw.x); r[2] = sigmoidf_(v0[2]) * bf_lo(pw.y); r[3] = sigmoidf_(v0[3]) * bf_hi(pw.y);
                    r[4] = sigmoidf_(v1[0]) * bf_lo(pw.z); r[5] = sigmoidf_(v1[1]) * bf_hi(pw.z); r[6] = sigmoidf_(v1[2]) * bf_lo(pw.w); r[7] = sigmoidf_(v1[3]) * bf_hi(pw.w);
                    if (b > 0) { const u32x4 mw = *(const u32x4*)(MIX + ro + bj * HALF);
                        r[0] += bf_lo(mw.x); r[1] += bf_hi(mw.x); r[2] += bf_lo(mw.y); r[3] += bf_hi(mw.y); r[4] += bf_lo(mw.z); r[5] += bf_hi(mw.z); r[6] += bf_lo(mw.w); r[7] += bf_hi(mw.w); }
                    u32x4 w; w.x = cvt_pk_bf16(r[0], r[1]); w.y = cvt_pk_bf16(r[2], r[3]); w.z = cvt_pk_bf16(r[4], r[5]); w.w = cvt_pk_bf16(r[6], r[7]);
                    *(u32x4*)(MIX + ro + bj * HALF) = w; } }
    }
};
struct EpiBranch {
    static constexpr bool PERM = true, AFTER_DRAIN = false;
    bf16_t* O;
    __device__ __forceinline__ void operator()(const f32x4 (&acc)[2][2][4][2], const Unit& u, int wr, int wc, int fr, int fq) const {
        const int row0 = u.pm * BM + wr * 64 + fr, col0 = (u.pn & 3) * BM + wc * 32 + 8 * fq;
#pragma unroll
        for (int ai = 0; ai < 2; ++ai)
#pragma unroll
            for (int m = 0; m < 4; ++m) { bf16_t* rowp = O + (size_t)(row0 + ai * HALF + m * 16) * 1024 + col0;
#pragma unroll
                for (int bj = 0; bj < 2; ++bj) { const f32x4 v0 = acc[ai][bj][m][0], v1 = acc[ai][bj][m][1];
                    u32x4 w; w.x = cvt_pk_bf16(v0[0], v0[1]); w.y = cvt_pk_bf16(v0[2], v0[3]); w.z = cvt_pk_bf16(v1[0], v1[1]); w.w = cvt_pk_bf16(v1[2], v1[3]);
                    *(u32x4*)(rowp + bj * HALF) = w; } }
    }
};
struct EpiResF32 {
    static constexpr bool PERM = false, AFTER_DRAIN = false;
    const float* base; float* out; int ldc; float alpha;
    __device__ __forceinline__ void operator()(const f32x4 (&acc)[2][2][4][2], const Unit& u, int wr, int wc, int fr, int fq) const {
        const int col0 = u.pn * BM + wc * 32 + 4 * fq;
#pragma unroll
        for (int ai = 0; ai < 2; ++ai)
#pragma unroll
            for (int m = 0; m < 4; ++m) { const size_t off = (size_t)(u.pm * BM + ai * HALF + wr * 64 + m * 16 + fr) * ldc + col0;
#pragma unroll
                for (int bj = 0; bj < 2; ++bj)
#pragma unroll
                    for (int n = 0; n < 2; ++n) { const f32x4 bs = *(const f32x4*)(base + off + bj * HALF + n * 16); *(f32x4*)(out + off + bj * HALF + n * 16) = bs * alpha + acc[ai][bj][m][n]; } }
    }
};
}
#define GAS __attribute__((address_space(1)))
#define LAS __attribute__((address_space(3)))
#define XB_TMO      128
#define XB_XCNT(j)  (256  + 64 * (j))
#define XB_XSUB(j)  (1280 + 64 * (j))
#define XB_XGEN(j)  (2304 + 64 * (j))
#define XB_TOP      3328
#define XB_TOPGEN   3392
#define XCD_BAR_WORDS 3456
#define XB_SPIN_CAP (1u << 18)

__device__ __forceinline__ unsigned xb_ld(unsigned* p)              { return __hip_atomic_load(p, __ATOMIC_RELAXED, __HIP_MEMORY_SCOPE_AGENT); }
__device__ __forceinline__ unsigned xb_add(unsigned* p, unsigned v) { return __hip_atomic_fetch_add(p, v, __ATOMIC_RELAXED, __HIP_MEMORY_SCOPE_AGENT); }
__device__ __forceinline__ unsigned xb_xcc_id() { return (unsigned)__builtin_amdgcn_s_getreg((3 << 11) | 20) & 0xFu; }
#define XB_SPIN(cond, bar) do { unsigned _sp = 0; while (cond) { __builtin_amdgcn_s_sleep(1); \
    if ((++_sp & 255u) == 0u) { if (xb_ld(&(bar)[XB_TMO])) break; if (_sp > XB_SPIN_CAP) { atomicAdd(&(bar)[XB_TMO], 1u); break; } } } } while (0)

struct XcdBarrier {
    unsigned* bar; unsigned x;
    volatile LAS unsigned* st;
};

__device__ __forceinline__ XcdBarrier xcd_barrier_post(unsigned* bar, volatile LAS unsigned* st, bool leader) {
    XcdBarrier b; b.bar = bar; b.x = xb_xcc_id(); b.st = st;
    if (leader) (void)xb_add(&bar[XB_XCNT(b.x)], 1u);
    return b;
}
__device__ __forceinline__ void xcd_barrier_complete(unsigned* bar, unsigned x, unsigned& nloc, unsigned& nx) {
    const unsigned G = gridDim.x * gridDim.y * gridDim.z;
    unsigned sum, cnt, mine, sp = 0u;
    for (;;) {
        sum = 0u; cnt = 0u; mine = 0u;
#pragma unroll
        for (unsigned j = 0; j < 16; ++j) { const unsigned c = xb_ld(&bar[XB_XCNT(j)]); sum += c; cnt += (c > 0u) ? 1u : 0u; mine = (j == x) ? c : mine; }
        if (sum == G) break;
        __builtin_amdgcn_s_sleep(1);
        if ((++sp & 255u) == 0u) { if (xb_ld(&bar[XB_TMO])) break; if (sp > XB_SPIN_CAP) { atomicAdd(&bar[XB_TMO], 1u); break; } }
    }
    nloc = mine > 0u ? mine : 1u; nx = cnt > 0u ? cnt : 1u;
}

__device__ __forceinline__ void xcd_barrier(const XcdBarrier& b, bool leader) {
    asm volatile("s_waitcnt vmcnt(0)" ::: "memory");
    __syncthreads();
    if (leader) {
        unsigned* bar = b.bar; unsigned bx_ = b.x; asm volatile("" : "+s"(bar), "+s"(bx_));
        __builtin_amdgcn_s_waitcnt(0);
        unsigned nloc = b.st[0], nx = b.st[1];
        if (nloc == 0u) { xcd_barrier_complete(bar, bx_, nloc, nx); b.st[0] = nloc; b.st[1] = nx; }
        const unsigned old = xb_add(&bar[XB_XSUB(bx_)], 1u);
        const unsigned gen = old / nloc;
        if (old + 1u == (gen + 1u) * nloc) {
            __builtin_amdgcn_fence(__ATOMIC_RELEASE, "agent");
            asm volatile("s_waitcnt vmcnt(0)" ::: "memory");
            const unsigned og = xb_add(&bar[XB_TOP], 1u);
            const unsigned tg = og / nx;
            if (og + 1u == (tg + 1u) * nx) xb_add(&bar[XB_TOPGEN], 1u);
            else XB_SPIN(xb_ld(&bar[XB_TOPGEN]) == tg, bar);
            __builtin_amdgcn_fence(__ATOMIC_ACQUIRE, "agent");
            xb_add(&bar[XB_XGEN(bx_)], 1u);
            asm volatile("s_waitcnt vmcnt(0)" ::: "memory");
        } else {
            XB_SPIN(xb_ld(&bar[XB_XGEN(bx_)]) == gen, bar);
            __builtin_amdgcn_fence(__ATOMIC_ACQUIRE, "agent");
            asm volatile("s_waitcnt vmcnt(0)" ::: "memory");
        }
    }
    __syncthreads();
}

constexpr int NWAVES = 8;
constexpr int BATCH = 2, SEQ = 16384, D = 1024, DEPTH = 4, M = BATCH * SEQ, INW = 3980, NEXP = 16384;
constexpr float ALPHA = 1.681792830507429f, LN_EPS = 1e-5f, QK_SCALE = 0.17677669529663687f, LOG2E = 1.4426950408889634f;
constexpr float ZC = QK_SCALE * LOG2E;
constexpr int C_SBQ = 0, C_SBK = 128, C_SBV = 256, C_NQ = 384, C_CK = 512, C_CV = 544, C_SK = 576, C_SV = 608, C_WK = 640, C_WV = 672, C_MQ = 704, C_MK = 832, C_MV = 864, C_NG = 896;

constexpr size_t MiB = 1u << 20;
constexpr size_t WS_CTL = 0, CTL_ZERO_BYTES = 1 * MiB;
constexpr size_t WS_WQKV = 1 * MiB;
constexpr size_t WS_WGATE = 9 * MiB;
constexpr size_t WS_WBR = 33 * MiB;
constexpr size_t WS_WOUT = 36 * MiB;
constexpr size_t WS_WQ = 44 * MiB;
constexpr size_t WS_PK = 52 * MiB;
constexpr size_t WS_KC = 53 * MiB;
constexpr size_t WS_VC = WS_KC + 256 * 1024;
constexpr size_t WS_KMEAN = WS_VC + 256 * 1024;
constexpr size_t WS_UQ = 54 * MiB;
constexpr size_t WS_VQ = 118 * MiB;
constexpr size_t WS_US = 182 * MiB, WS_VS = WS_US + 256 * 1024;
constexpr size_t WS_X = 310 * MiB;
constexpr size_t WS_X1 = 438 * MiB;
constexpr size_t WS_XB = 566 * MiB;
constexpr size_t WS_QKV = 630 * MiB;
constexpr size_t WS_OCAT = 694 * MiB;
constexpr size_t WS_P = 718 * MiB;
constexpr size_t WS_Y = WS_P, WS_QP = WS_P + 128 * MiB;
constexpr size_t WS_END = 910 * MiB;
constexpr size_t WS_KR = 910 * MiB, WS_VF = 926 * MiB, WS_KMH = 942 * MiB, WS_KML = WS_KMH + 64 * 1024, WS_NACC = 943 * MiB  , WS_END2 = 959 * MiB;
constexpr size_t WS_WCT = WS_KMH + 128 * 1024;
constexpr size_t WS_PEW = WS_KMH + 704 * 1024;
constexpr int CW_BAR = 4096;

constexpr int RING_OFF = 0, RING_BYTES = 131072;
constexpr int LDSCTL_OFF = RING_BYTES, MISC_OFF = LDSCTL_OFF + 320;
constexpr int LDS_BYTES = 147456;

typedef unsigned short bf16;
typedef unsigned v4u __attribute__((ext_vector_type(4)));
typedef float f32x4 __attribute__((ext_vector_type(4)));
typedef short bf16x8 __attribute__((ext_vector_type(8)));
#define LDS_WAIT() asm volatile("s_waitcnt lgkmcnt(0)" ::: "memory")

__device__ __forceinline__ unsigned f2bf(float f) { unsigned u = __builtin_bit_cast(unsigned, f); return (u + 0x7fffu + ((u >> 16) & 1u)) >> 16; }
__device__ __forceinline__ unsigned pk2(float lo, float hi) { return f2bf(lo) | (f2bf(hi) << 16); }
__device__ __forceinline__ float bflo(unsigned w) { return __uint_as_float(w << 16); }
__device__ __forceinline__ float bfhi(unsigned w) { return __uint_as_float(w & 0xffff0000u); }
__device__ __forceinline__ float bf1(bf16 h) { return __uint_as_float((unsigned)h << 16); }
__device__ __forceinline__ void unpack8(const v4u w, float* o) { o[0] = bflo(w.x); o[1] = bfhi(w.x); o[2] = bflo(w.y); o[3] = bfhi(w.y); o[4] = bflo(w.z); o[5] = bfhi(w.z); o[6] = bflo(w.w); o[7] = bfhi(w.w); }
__device__ __forceinline__ void load32bf(const bf16* p, float* o) {
    const v4u* q = (const v4u*)p; const v4u a = q[0], b = q[1], c = q[2], d = q[3];
    unpack8(a, o); unpack8(b, o + 8); unpack8(c, o + 16); unpack8(d, o + 24);
}
__device__ __forceinline__ void load32f(const float* p, float* o) {
    const f32x4* q = (const f32x4*)p;
#pragma unroll
    for (int i = 0; i < 8; ++i) { const f32x4 v = q[i]; o[4 * i] = v.x; o[4 * i + 1] = v.y; o[4 * i + 2] = v.z; o[4 * i + 3] = v.w; }
}
__device__ __forceinline__ void store32bf(bf16* p, const float* o) {
    v4u* q = (v4u*)p;
#pragma unroll
    for (int i = 0; i < 4; ++i) { v4u w; w.x = pk2(o[8 * i], o[8 * i + 1]); w.y = pk2(o[8 * i + 2], o[8 * i + 3]); w.z = pk2(o[8 * i + 4], o[8 * i + 5]); w.w = pk2(o[8 * i + 6], o[8 * i + 7]); q[i] = w; }
}
__device__ __forceinline__ float dot32(const float* a, const float* b) {
    float s0 = 0.f, s1 = 0.f, s2 = 0.f, s3 = 0.f;
#pragma unroll
    for (int i = 0; i < 32; i += 4) { s0 = fmaf(a[i], b[i], s0); s1 = fmaf(a[i + 1], b[i + 1], s1); s2 = fmaf(a[i + 2], b[i + 2], s2); s3 = fmaf(a[i + 3], b[i + 3], s3); }
    return (s0 + s1) + (s2 + s3);
}
__device__ __forceinline__ float ex2(float x) { return __builtin_amdgcn_exp2f(x); }
__device__ __forceinline__ float lg2(float x) { return __builtin_amdgcn_logf(x); }
__device__ __forceinline__ float shx(float v, int mask, int lane) { return __int_as_float(__builtin_amdgcn_ds_bpermute((lane ^ mask) << 2, __float_as_int(v))); }
__device__ __forceinline__ int shxi(int v, int mask, int lane) { return __builtin_amdgcn_ds_bpermute((lane ^ mask) << 2, v); }
__device__ __forceinline__ float wave_sum(float v, int lane) {
#pragma unroll
    for (int o = 1; o < 64; o <<= 1) v += shx(v, o, lane);
    return v;
}
__device__ __forceinline__ float quad_sum(float v, int lane) { v += shx(v, 1, lane); v += shx(v, 2, lane); return v; }
__device__ __forceinline__ int lane_id() { int l; asm volatile("v_mbcnt_lo_u32_b32 %0, -1, 0\n\tv_mbcnt_hi_u32_b32 %0, -1, %0" : "=v"(l)); return l; }
__device__ __forceinline__ int opq(int v) { asm volatile("" : "+s"(v)); return v; }
__device__ __forceinline__ unsigned char* opq_ptr(unsigned char* p) { asm volatile("" : "+s"(p)); return p; }
__device__ __forceinline__ int lane_zero() { int z; asm volatile("v_mov_b32 %0, 0" : "=v"(z)); return z; }

struct Ptrs {
    const float* in[19]; float* out; unsigned char* ws;
};

__device__ __forceinline__ void load_row16(const float* row, int lane, float* v);
__device__ __forceinline__ void tr_item(const float* W, int pitch, int scol, int ncols, int K, int k0, bf16* WT, int drow0, LAS float* scr, int lane) {
#pragma unroll 8
    for (int i = 0; i < 32; ++i) { const int kk = 2 * i + (lane >> 5), c = lane & 31; scr[kk * 33 + c] = (c < ncols) ? W[(size_t)(k0 + kk) * pitch + scol + c] : 0.f; }
    LDS_WAIT(); asm volatile("" ::: "memory");
    const int c8 = lane & 7;
#pragma unroll
    for (int j = 0; j < 4; ++j) { const int n = (lane >> 3) + 8 * j; const LAS float* s = scr + (8 * c8) * 33 + n;
        v4u o; o.x = pk2(s[0 * 33], s[1 * 33]); o.y = pk2(s[2 * 33], s[3 * 33]); o.z = pk2(s[4 * 33], s[5 * 33]); o.w = pk2(s[6 * 33], s[7 * 33]);
        *(v4u*)(WT + (size_t)(drow0 + n) * K + k0 + 8 * c8) = o; }
    LDS_WAIT(); asm volatile("" ::: "memory");
}
__device__ __forceinline__ void cvt8(const float* src, bf16* dst) {
    const f32x4 a = *(const f32x4*)src, b = *(const f32x4*)(src + 4);
    v4u w; w.x = pk2(a.x, a.y); w.y = pk2(a.z, a.w); w.z = pk2(b.x, b.y); w.w = pk2(b.z, b.w); *(v4u*)dst = w;
}
__device__ __forceinline__ void prologue(const Ptrs& A, LAS unsigned char* lds, int vcu, int NGW, int wave) {
    const int lane = lane_id(), gw = vcu * NWAVES + wave;
    LAS float* scr = (LAS float*)(lds + RING_OFF + wave * 16384);
    unsigned char* ws = opq_ptr(A.ws);
    constexpr int IT_QKV = 16 * 32, IT_GATE = 16 * 96, IT_BR = 2 * 32, IT_OUT = 16 * 32, IT_WQ = 16 * 32, IT_L = IT_QKV + IT_GATE + 3 * IT_BR + IT_OUT + IT_WQ;
    for (int it = gw; it < DEPTH * IT_L; it += NGW) {
        const int l = it / IT_L; int r = it % IT_L;
        if (r < IT_QKV) { const int kb = r >> 5, di = r & 31; int scol, nc;
            if (di < 22) { scol = 32 * di; nc = 32; } else if (di < 26) { scol = 716 + 32 * (di - 22); nc = 32; } else if (di == 26) { scol = 844; nc = 32; } else if (di == 27) { scol = 876; nc = 32; }
            else if (di == 28) { scol = 704; nc = 12; } else { scol = 0; nc = 0; }
            tr_item(A.in[1] + (size_t)l * D * INW, INW, scol, nc, D, kb * 64, (bf16*)(ws + WS_WQKV) + (size_t)l * 1024 * 1024, di * 32, scr, lane); continue; }
        r -= IT_QKV;
        if (r < IT_GATE) { const int kb = r / 96, ni = r % 96;
            tr_item(A.in[1] + (size_t)l * D * INW, INW, 908 + 32 * ni, 32, D, kb * 64, (bf16*)(ws + WS_WGATE) + (size_t)l * 3072 * 1024, ni * 32, scr, lane); continue; }
        r -= IT_GATE;
        if (r < 3 * IT_BR) { const int b = r / IT_BR, q = r % IT_BR, kb = q >> 5, ni = q & 31;
            tr_item(A.in[6 + b] + (size_t)l * 128 * D, D, 32 * ni, 32, 128, kb * 64, (bf16*)(ws + WS_WBR) + (size_t)(l * 3 + b) * 1024 * 128, ni * 32, scr, lane); continue; }
        r -= 3 * IT_BR;
        if (r < IT_OUT) { const int kb = r >> 5, ni = r & 31;
            tr_item(A.in[9] + (size_t)l * D * D, D, 32 * ni, 32, D, kb * 64, (bf16*)(ws + WS_WOUT) + (size_t)l * 1024 * 1024, ni * 32, scr, lane); continue; }
        r -= IT_OUT;
        { const int kb = r >> 5, ni = r & 31;
            tr_item(A.in[12] + (size_t)l * D * D, D, 32 * ni, 32, D, kb * 64, (bf16*)(ws + WS_WQ) + (size_t)l * 1024 * 1024, ni * 32, scr, lane); }
    }
    for (int it = gw; it < DEPTH * 2 * 16; it += NGW) { const int lk = it >> 4, kb = it & 15, ll = lk >> 1, kv = lk & 1;
        tr_item(A.in[kv ? 5 : 4] + (size_t)ll * 1024 * 32, 32, 0, 32, 1024, kb * 64, (bf16*)(ws + WS_WCT) + (size_t)lk * 32 * 1024, 0, scr, lane); }
    for (int it = gw; it < DEPTH * 2; it += NGW) { const int ll = it >> 1, kv = it & 1, d = lane & 31, hf = lane >> 5;
        const float* pe = A.in[kv ? 3 : 2] + (size_t)ll * 1024; const float* w = A.in[kv ? 5 : 4] + (size_t)ll * 1024 * 32; float s = 0.f;
        for (int f = hf * 512; f < hf * 512 + 512; ++f) s = fmaf(pe[f], w[(size_t)f * 32 + d], s);
        s += shx(s, 32, lane);
        if (hf == 0) ((float*)(ws + WS_PEW))[it * 32 + d] = s; }
    const size_t gt = (size_t)gw * 64 + lane, NT = (size_t)NGW * 64;
    for (int rw = gw; rw < 2 * DEPTH * NEXP; rw += NGW) { const int tb = rw / (DEPTH * NEXP), row = rw % (DEPTH * NEXP);
        float v[16]; load_row16(A.in[15 + tb] + (size_t)row * D, lane, v);
        float am = 0.f;
#pragma unroll
        for (int i = 0; i < 16; ++i) am = fmaxf(am, fabsf(v[i]));
#pragma unroll
        for (int o = 1; o < 64; o <<= 1) am = fmaxf(am, shx(am, o, lane));
        const float inv = am > 0.f ? 127.0f / am : 0.f; unsigned q[16];
#pragma unroll
        for (int i = 0; i < 16; ++i) q[i] = (unsigned)(int)(rintf(v[i] * inv) + 128.0f);
        v4u w; w.x = q[0] | (q[1] << 8) | (q[2] << 16) | (q[3] << 24); w.y = q[4] | (q[5] << 8) | (q[6] << 16) | (q[7] << 24); w.z = q[8] | (q[9] << 8) | (q[10] << 16) | (q[11] << 24); w.w = q[12] | (q[13] << 8) | (q[14] << 16) | (q[15] << 24);
        *(v4u*)(ws + (tb ? WS_VQ : WS_UQ) + (size_t)row * D + 16 * lane) = w;
        if (lane == 0) ((float*)(ws + (tb ? WS_VS : WS_US)))[row] = am * (1.0f / 127.0f); }
    { const size_t n8 = (size_t)M * D / 8; bf16* xb = (bf16*)(ws + WS_XB);
      for (size_t i = gt; i < n8; i += NT) cvt8(A.in[0] + i * 8, xb + i * 8); }
    { const size_t n8 = (size_t)DEPTH * 4 * 128 * 128 / 8; bf16* pk = (bf16*)(ws + WS_PK);
      for (size_t i = gt; i < n8; i += NT) { const size_t e = i * 8, lh = e >> 14, rest = e & 16383;
          cvt8(A.in[13] + e, pk + (lh * 2 + 0) * 16384 + rest); cvt8(A.in[14] + e, pk + (lh * 2 + 1) * 16384 + rest); } }
}

__device__ __forceinline__ void prep_phase(const Ptrs& A, int l, int vcu, int NGW, int wave) {
    const int lane = lane_id(), gw = vcu * NWAVES + wave;
    unsigned char* ws = opq_ptr(A.ws); const bf16* QKV = (const bf16*)(ws + WS_QKV);
    const int d = lane & 31, hf = lane >> 5, lz = lane_zero();
    for (int it = gw; it < 4092 + 128; it += NGW) {
        if (it < 4092) {
            const int kv = it / 2046, rr = it % 2046, b = rr / 1023, n = rr % 1023;
            const float* pe = A.in[kv ? 3 : 2] + (size_t)l * 1024; const float* w = A.in[kv ? 5 : 4] + (size_t)l * 1024 * 32;
            float acc = 0.f;
            for (int jj = 0; jj < 16; ++jj) { const int j = hf * 16 + jj; float c[32];
                load32bf(QKV + (size_t)(b * SEQ + 16 * n + j) * 1024 + (kv ? C_CV : C_CK) + lz, c);
#pragma unroll
                for (int e = 0; e < 32; ++e) acc = fmaf(c[e] + pe[j * 32 + e], w[(size_t)(j * 32 + e) * 32 + d], acc); }
            acc += shx(acc, 32, lane);
            if (hf == 0) ((float*)(ws + (kv ? WS_VC : WS_KC)))[(size_t)(b * 1024 + n) * 32 + d] = acc;
        } else {
            const int r = it - 4092, b = r >> 6, blk = r & 63; float s = 0.f;
            const bf16* p = QKV + (size_t)(b * SEQ + blk * 256 + hf * 128) * 1024 + C_MK + d;
            for (int i = 0; i < 128; ++i) s += bf1(p[(size_t)i * 1024]);
            s += shx(s, 32, lane);
            if (hf == 0) ((float*)(ws + WS_KMEAN))[(size_t)(b * 64 + blk) * 32 + d] = s * (1.0f / 256.0f);
        }
    }
}

struct OnlineSm { float m, l; };
__device__ __forceinline__ void osm_step(OnlineSm& s, float* o, float z2, bool valid, const float* v) {
    const float mn = valid ? fmaxf(s.m, z2) : s.m;
    const float a = ex2(s.m - mn);
    const float al = (s.m == mn) ? 1.0f : a;
    const float p = valid ? ex2(z2 - mn) : 0.f;
    s.l = s.l * al + p; s.m = mn;
#pragma unroll
    for (int i = 0; i < 32; ++i) o[i] = fmaf(p, v[i], o[i] * al);
}

__device__ __forceinline__ void sb_item(unsigned char* ws, int item, int lane) {
    const bf16* QKV = (const bf16*)(ws + WS_QKV); bf16* OSB = (bf16*)(ws + WS_OCAT);
    const int b = item >> 10, h = (item >> 8) & 3, g = item & 255, t = g * 64 + lane, lz = lane_zero();
    float q[32], o[32];
    load32bf(QKV + (size_t)(b * SEQ + t) * 1024 + C_SBQ + h * 32, q);
#pragma unroll
    for (int i = 0; i < 32; ++i) o[i] = 0.f;
    float carry = 0.f;
    const bf16* kb = QKV + (size_t)b * SEQ * 1024 + C_SBK + h * 32 + lz; const bf16* vb = QKV + (size_t)b * SEQ * 1024 + C_SBV + h * 32 + lz;
    for (int s = g * 64 + 62; s >= 0; --s) {
        float k[32], v[32];
        load32bf(kb + (size_t)s * 1024, k); load32bf(vb + (size_t)s * 1024, v);
        const float z2 = dot32(q, k) * ZC;
        const float sp = fmaxf(z2, 0.f) + lg2(1.0f + ex2(-fabsf(z2)));
        const bool valid = s < t;
        const float w = valid ? ex2(z2 - sp + carry) : 0.f;
        carry -= valid ? sp : 0.f;
#pragma unroll
        for (int i = 0; i < 32; ++i) o[i] = fmaf(w, v[i], o[i]);
        if (__all(carry < -151.0f)) break;
    }
    store32bf(OSB + (size_t)(b * SEQ + t) * 128 + h * 32, o);
}

__device__ __forceinline__ void nsa_item(unsigned char* ws, int b, int tg, int lane) {
    const bf16* QKV = (const bf16*)(ws + WS_QKV); bf16* ONSA = (bf16*)(ws + WS_OCAT) + (size_t)M * 128;
    const float* KC = (const float*)(ws + WS_KC) + (size_t)b * 1024 * 32; const float* VC = (const float*)(ws + WS_VC) + (size_t)b * 1024 * 32;
    const int t0 = tg * 16, h = lane & 3, t = t0 + (lane >> 2), lz = lane_zero(), cur = t >> 6;
    const size_t row = (size_t)(b * SEQ + t) * 1024;
    const float slope2 = LOG2E * (h == 0 ? 0.5f : h == 1 ? 0.125f : h == 2 ? 0.03125f : 0.0078125f);
    float q[32], out[32];
    load32bf(QKV + row + C_NQ + h * 32, q);
    const float g0 = 1.0f / (1.0f + __expf(-bf1(QKV[row + C_NG + h * 3 + 0]))), g1 = 1.0f / (1.0f + __expf(-bf1(QKV[row + C_NG + h * 3 + 1]))), g2 = 1.0f / (1.0f + __expf(-bf1(QKV[row + C_NG + h * 3 + 2])));
    const int ncnt = (t0 + 15 >= 31) ? ((t0 + 15 - 31) >> 4) + 1 : 0;
    float m = -INFINITY, l = 0.f;
    for (int n = 0; n < ncnt; ++n) { float k[32]; load32f(KC + (size_t)n * 32 + lz, k);
        const int dc = t - (16 * n + 31); const float z2 = dot32(q, k) * ZC - slope2 * (float)dc;
        if (dc >= 0) { const float mn = fmaxf(m, z2); l = l * ((m == mn) ? 1.0f : ex2(m - mn)) + ex2(z2 - mn); m = mn; } }
    const float inv_l = (l > 0.f) ? 1.0f / l : 0.f;
    float tv[5], o[32]; int ti[5];
#pragma unroll
    for (int i = 0; i < 5; ++i) { tv[i] = -1.0f; ti[i] = -1; }
#pragma unroll
    for (int i = 0; i < 32; ++i) o[i] = 0.f;
    float Pprev = 0.f, acc = 0.f;
    for (int n = 0; n < ncnt; ++n) { float k[32], v[32]; load32f(KC + (size_t)n * 32 + lz, k); load32f(VC + (size_t)n * 32 + lz, v);
        const int dc = t - (16 * n + 31); const float z2 = dot32(q, k) * ZC - slope2 * (float)dc;
        const float p = (dc >= 0) ? ex2(z2 - m) * inv_l : 0.f;
#pragma unroll
        for (int i = 0; i < 32; ++i) o[i] = fmaf(p, v[i], o[i]);
        const float P = quad_sum(p, lane); const int r = n & 3, j = n >> 2;
        acc = (r == 0) ? (Pprev + 2.0f * P) : (r == 3 ? acc + P : acc + 2.0f * P);
        Pprev = P;
        if (r == 3) {
            const bool ins = (j >= 1) && (j <= cur - 2) && (acc > tv[4]);
            tv[4] = ins ? acc : tv[4]; ti[4] = ins ? j : ti[4];
#pragma unroll
            for (int kk = 4; kk >= 1; --kk) { const bool sw = tv[kk] > tv[kk - 1];
                const float fa = tv[kk], fb = tv[kk - 1]; const int ia = ti[kk], ib = ti[kk - 1];
                tv[kk - 1] = sw ? fa : fb; tv[kk] = sw ? fb : fa; ti[kk - 1] = sw ? ia : ib; ti[kk] = sw ? ib : ia; }
        }
    }
#pragma unroll
    for (int i = 0; i < 32; ++i) out[i] = g0 * o[i];
    {
        OnlineSm sm{-INFINITY, 0.f};
#pragma unroll
        for (int i = 0; i < 32; ++i) o[i] = 0.f;
        const bf16* kb = QKV + (size_t)b * SEQ * 1024 + C_SK; const bf16* vb = QKV + (size_t)b * SEQ * 1024 + C_SV;
        for (int slot = 0; slot < 8; ++slot) {
            const int blk = slot == 0 ? 0 : slot == 1 ? (cur >= 2 ? cur - 1 : -1) : slot == 2 ? (cur >= 1 ? cur : -1) : slot == 3 ? ti[0] : slot == 4 ? ti[1] : slot == 5 ? ti[2] : slot == 6 ? ti[3] : ti[4];
            if (__all(blk < 0)) continue;
            const int bb = blk < 0 ? 0 : blk;
            for (int kk = 0; kk < 64; ++kk) { const int pos = bb * 64 + kk; float k[32], v[32];
                load32bf(kb + (size_t)pos * 1024, k); load32bf(vb + (size_t)pos * 1024, v);
                const float z2 = dot32(q, k) * ZC - slope2 * (float)(t - pos);
                osm_step(sm, o, z2, blk >= 0 && pos <= t, v); }
        }
        const float il = 1.0f / sm.l;
#pragma unroll
        for (int i = 0; i < 32; ++i) out[i] = fmaf(g1 * il, o[i], out[i]);
    }
    {
        OnlineSm sm{-INFINITY, 0.f};
#pragma unroll
        for (int i = 0; i < 32; ++i) o[i] = 0.f;
        const bf16* kb = QKV + (size_t)b * SEQ * 1024 + C_WK + lz; const bf16* vb = QKV + (size_t)b * SEQ * 1024 + C_WV + lz;
        const int p0 = (t0 - 511 > 0) ? t0 - 511 : 0;
        for (int pos = p0; pos <= t0 + 15; ++pos) { float k[32], v[32];
            load32bf(kb + (size_t)pos * 1024, k); load32bf(vb + (size_t)pos * 1024, v);
            const int dw = t - pos; const float z2 = dot32(q, k) * ZC - slope2 * (float)dw;
            osm_step(sm, o, z2, dw >= 0 && dw < 512, v); }
        const float il = 1.0f / sm.l;
#pragma unroll
        for (int i = 0; i < 32; ++i) out[i] = fmaf(g2 * il, o[i], out[i]);
    }
    store32bf(ONSA + (size_t)(b * SEQ + t) * 128 + h * 32, out);
}

__device__ __forceinline__ void moba_item(unsigned char* ws, int b, int tg, int lane) {
    const bf16* QKV = (const bf16*)(ws + WS_QKV); bf16* OMB = (bf16*)(ws + WS_OCAT) + (size_t)2 * M * 128;
    const float* KM = (const float*)(ws + WS_KMEAN) + (size_t)b * 64 * 32;
    const int t0 = tg * 16, h = lane & 3, t = t0 + (lane >> 2), lz = lane_zero(), cur = t0 >> 8;
    const float slope2 = LOG2E * (h == 0 ? 0.25f : h == 1 ? 0.0625f : h == 2 ? 0.015625f : 0.00390625f);
    float q[32], o[32];
    load32bf(QKV + (size_t)(b * SEQ + t) * 1024 + C_MQ + h * 32, q);
    float tv[3]; int ti[3];
#pragma unroll
    for (int i = 0; i < 3; ++i) { tv[i] = -INFINITY; ti[i] = -1; }
    for (int n = 0; n < cur; ++n) { float k[32]; load32f(KM + (size_t)n * 32 + lz, k);
        const float sg = quad_sum(dot32(q, k), lane);
        const bool ins = sg > tv[2]; tv[2] = ins ? sg : tv[2]; ti[2] = ins ? n : ti[2];
#pragma unroll
        for (int kk = 2; kk >= 1; --kk) { const bool sw = tv[kk] > tv[kk - 1];
            const float fa = tv[kk], fb = tv[kk - 1]; const int ia = ti[kk], ib = ti[kk - 1];
            tv[kk - 1] = sw ? fa : fb; tv[kk] = sw ? fb : fa; ti[kk - 1] = sw ? ia : ib; ti[kk] = sw ? ib : ia; }
    }
    OnlineSm sm{-INFINITY, 0.f};
#pragma unroll
    for (int i = 0; i < 32; ++i) o[i] = 0.f;
    const bf16* kb = QKV + (size_t)b * SEQ * 1024 + C_MK; const bf16* vb = QKV + (size_t)b * SEQ * 1024 + C_MV;
    for (int slot = 0; slot < 3; ++slot) {
        const int blk = slot == 0 ? ti[0] : slot == 1 ? ti[1] : ti[2];
        if (__all(blk < 0)) continue;
        const int bb = blk < 0 ? 0 : blk;
        for (int kk = 0; kk < 256; ++kk) { const int pos = bb * 256 + kk; float k[32], v[32];
            load32bf(kb + (size_t)pos * 1024, k); load32bf(vb + (size_t)pos * 1024, v);
            const float z2 = dot32(q, k) * ZC - slope2 * (float)(t - pos);
            osm_step(sm, o, z2, blk >= 0, v); }
    }
    for (int pos = cur * 256; pos <= t0 + 15; ++pos) { float k[32], v[32];
        load32bf(kb + (size_t)pos * 1024 + lz, k); load32bf(vb + (size_t)pos * 1024 + lz, v);
        const float z2 = dot32(q, k) * ZC - slope2 * (float)(t - pos);
        osm_step(sm, o, z2, pos <= t, v); }
    const float il = 1.0f / sm.l;
#pragma unroll
    for (int i = 0; i < 32; ++i) o[i] *= il;
    store32bf(OMB + (size_t)(b * SEQ + t) * 128 + h * 32, o);
}

__device__ __forceinline__ void attn_phase_simple(unsigned char* ws_, int vcu, int wave) {
    unsigned char* ws = opq_ptr(ws_);
    const int lane = lane_id();
#ifndef NO_NSA
    { const int k = vcu * 4 + (wave & 3); if (wave < 4) nsa_item(ws, 0, k, lane); else nsa_item(ws, 1, 1023 - k, lane); }
#endif
#ifndef NO_MOBA
    { const int it = vcu * 8 + wave; moba_item(ws, it >> 10, it & 1023, lane); }
#endif
#ifndef NO_SB
    sb_item(ws, vcu * 8 + wave, lane);
#endif
}


constexpr size_t KRV_BR = (size_t)BATCH * SEQ * 32;
typedef float f32x4a __attribute__((ext_vector_type(4)));
#define MFMA16(a, b, c) __builtin_amdgcn_mfma_f32_16x16x32_bf16(a, b, c, 0, 0, 0)
typedef const GAS bf16* gcb;
typedef GAS bf16* gb;
typedef unsigned u32x2 __attribute__((ext_vector_type(2)));
__device__ __forceinline__ bf16x8 ld8(gcb p) { return __builtin_bit_cast(bf16x8, *(const GAS v4u*)p); }
typedef float f32x2c __attribute__((ext_vector_type(2))); typedef __bf16 bf16x2c __attribute__((ext_vector_type(2)));
__device__ __forceinline__ unsigned cvtpk(float lo, float hi) { const f32x2c v = {lo, hi}; const bf16x2c b = __builtin_convertvector(v, bf16x2c); return __builtin_bit_cast(unsigned, b); }
__device__ __forceinline__ bf16x8 pack_p(const f32x4 p0, const f32x4 p1) { v4u w; w.x = cvtpk(p0[0], p0[1]); w.y = cvtpk(p0[2], p0[3]); w.z = cvtpk(p1[0], p1[1]); w.w = cvtpk(p1[2], p1[3]); return __builtin_bit_cast(bf16x8, w); }
__device__ __forceinline__ float max8(const f32x4 a, const f32x4 b) { return fmaxf(fmaxf(fmaxf(a[0], a[1]), fmaxf(a[2], a[3])), fmaxf(fmaxf(b[0], b[1]), fmaxf(b[2], b[3]))); }
__device__ __forceinline__ float quadall_max(float v, int lane) { v = fmaxf(v, shx(v, 16, lane)); v = fmaxf(v, shx(v, 32, lane)); return v; }
__device__ __forceinline__ float quadall_sum(float v, int lane) { v += shx(v, 16, lane); v += shx(v, 32, lane); return v; }

__device__ __forceinline__ void prep2_phase(const Ptrs& A, LAS unsigned char* lds, int l, int vcu, int NGW, int wave) {
    const int lane = lane_id(), gw = vcu * NWAVES + wave;
    GAS unsigned char* ws = (GAS unsigned char*)opq_ptr(A.ws); gcb QKV = (gcb)(ws + WS_QKV);
    gb KR = (gb)(ws + WS_KR); gb VF = (gb)(ws + WS_VF);
    LAS bf16* scr = (LAS bf16*)(lds + RING_OFF + wave * 16384);
    const int c = lane & 15, quad = lane >> 4;
    constexpr int N_PACK = 7 * 2 * 512, N_CMP = 2 * 2 * 64, N_KM = 128;
    for (int it = gw; it < N_PACK + N_CMP + N_KM; it += NGW) {
        if (it < N_PACK) {
            const int br = it >> 10, b = (it >> 9) & 1, g = it & 511;
            const int kcol = br == 0 ? C_WK : br == 1 ? C_SK : br == 2 ? C_MK : C_SBK + 32 * (br - 3), vcol = br == 0 ? C_WV : br == 1 ? C_SV : br == 2 ? C_MV : C_SBV + 32 * (br - 3);
            gcb src = QKV + (size_t)(b * SEQ + 32 * g) * 1024;
            const int key = lane >> 1, half = lane & 1;
            const v4u x0 = *(const GAS v4u*)(src + (size_t)key * 1024 + kcol + 16 * half), x1 = *(const GAS v4u*)(src + (size_t)key * 1024 + kcol + 16 * half + 8);
            const v4u y0 = *(const GAS v4u*)(src + (size_t)key * 1024 + vcol + 16 * half), y1 = *(const GAS v4u*)(src + (size_t)key * 1024 + vcol + 16 * half + 8);
            gb dst = KR + (size_t)br * KRV_BR + (size_t)(b * SEQ + 32 * g + key) * 32 + 16 * half; *(GAS v4u*)dst = x0; *(GAS v4u*)(dst + 8) = x1;
            *(LAS v4u*)(scr + key * 32 + 16 * half) = y0; *(LAS v4u*)(scr + key * 32 + 16 * half + 8) = y1;
            asm volatile("s_waitcnt lgkmcnt(0)" ::: "memory");
#pragma unroll
            for (int dt = 0; dt < 2; ++dt) { unsigned e[8];
#pragma unroll
                for (int j = 0; j < 8; ++j) { const int kj = (j < 4) ? 4 * quad + j : 16 + 4 * quad + (j - 4); e[j] = scr[kj * 32 + 16 * dt + c]; }
                v4u w; w.x = e[0] | (e[1] << 16); w.y = e[2] | (e[3] << 16); w.z = e[4] | (e[5] << 16); w.w = e[6] | (e[7] << 16);
                *(GAS v4u*)(VF + (size_t)br * KRV_BR + ((size_t)(b * 512 + g) * 2 + dt) * 512 + lane * 8) = w; }
            asm volatile("s_waitcnt lgkmcnt(0)" ::: "memory");
        } else if (it < N_PACK + N_CMP) {
            const int r0 = it - N_PACK, kv = r0 >> 7, b = (r0 >> 6) & 1, n0 = (r0 & 63) * 16, n = n0 + c;
            gcb wct = (gcb)(ws + WS_WCT) + (size_t)(l * 2 + kv) * 32 * 1024;
            gcb ckp = QKV + (size_t)(b * SEQ + 16 * n) * 1024 + (kv ? C_CV : C_CK) + 8 * quad;
            f32x4 acc0 = {0.f, 0.f, 0.f, 0.f}, acc1 = acc0;
#pragma unroll 4
            for (int ks = 0; ks < 32; ++ks) {
                const bf16x8 bq = ld8(ckp + (size_t)ks * 1024);
                const bf16x8 a0 = ld8(wct + (size_t)c * 1024 + 32 * ks + 8 * quad), a1 = ld8(wct + (size_t)(16 + c) * 1024 + 32 * ks + 8 * quad);
                acc0 = MFMA16(a0, bq, acc0); acc1 = MFMA16(a1, bq, acc1); }
            const GAS float* pew = (const GAS float*)(ws + WS_PEW) + (l * 2 + kv) * 32;
            const f32x4 p0 = *(const GAS f32x4*)(pew + 4 * quad), p1 = *(const GAS f32x4*)(pew + 16 + 4 * quad);
            const bool live = n < 1023;
            acc0 = live ? acc0 + p0 : (f32x4){0.f, 0.f, 0.f, 0.f}; acc1 = live ? acc1 + p1 : (f32x4){0.f, 0.f, 0.f, 0.f};
            if (kv == 0) { u32x2 w0, w1; w0.x = cvtpk(acc0[0], acc0[1]); w0.y = cvtpk(acc0[2], acc0[3]); w1.x = cvtpk(acc1[0], acc1[1]); w1.y = cvtpk(acc1[2], acc1[3]);
                gb kp = KR + (size_t)7 * KRV_BR + (size_t)(b * SEQ + n) * 32 + 4 * quad; *(GAS u32x2*)kp = w0; *(GAS u32x2*)(kp + 16) = w1; }
            else { const int g = n >> 5, nn = n & 31, rr = nn & 15, qn = rr >> 2, jj = (rr & 3) + 4 * (nn >> 4);
#pragma unroll
                for (int r = 0; r < 4; ++r) {
                    VF[(size_t)7 * KRV_BR + ((size_t)(b * 512 + g) * 2 + 0) * 512 + ((4 * quad + r) + 16 * qn) * 8 + jj] = (bf16)f2bf(acc0[r]);
                    VF[(size_t)7 * KRV_BR + ((size_t)(b * 512 + g) * 2 + 1) * 512 + ((4 * quad + r) + 16 * qn) * 8 + jj] = (bf16)f2bf(acc1[r]); } }
        } else {
            const int r = it - N_PACK - N_CMP, b = r >> 6, blk = r & 63, tk16 = lane >> 2, dq = lane & 3;
            gcb p = QKV + (size_t)(b * SEQ + blk * 256 + tk16) * 1024 + C_MK + 8 * dq;
            float s[8];
#pragma unroll
            for (int i = 0; i < 8; ++i) s[i] = 0.f;
#pragma unroll 4
            for (int i = 0; i < 16; ++i) { float f[8]; unpack8(*(const GAS v4u*)(p + (size_t)i * 16 * 1024), f);
#pragma unroll
                for (int k = 0; k < 8; ++k) s[k] += f[k]; }
#pragma unroll
            for (int k = 0; k < 8; ++k) { float v = s[k]; v += shx(v, 4, lane); v += shx(v, 8, lane); v += shx(v, 16, lane); v += shx(v, 32, lane); s[k] = v * (1.0f / 256.0f); }
            if (lane < 4) { unsigned hi[8], lo[8];
#pragma unroll
                for (int k = 0; k < 8; ++k) { hi[k] = f2bf(s[k]); lo[k] = f2bf(s[k] - __uint_as_float(hi[k] << 16)); }
                v4u wh, wl; wh.x = hi[0] | (hi[1] << 16); wh.y = hi[2] | (hi[3] << 16); wh.z = hi[4] | (hi[5] << 16); wh.w = hi[6] | (hi[7] << 16);
                wl.x = lo[0] | (lo[1] << 16); wl.y = lo[2] | (lo[3] << 16); wl.z = lo[4] | (lo[5] << 16); wl.w = lo[6] | (lo[7] << 16);
                *(GAS v4u*)((gb)(ws + WS_KMH) + (size_t)(b * 64 + blk) * 32 + 8 * dq) = wh; *(GAS v4u*)((gb)(ws + WS_KML) + (size_t)(b * 64 + blk) * 32 + 8 * dq) = wl; }
        }
    }
}

struct Col { f32x4 o0, o1; float m, l; };
__device__ __forceinline__ void col_init(Col& c) { c.o0 = (f32x4){0.f, 0.f, 0.f, 0.f}; c.o1 = c.o0; c.m = -INFINITY; c.l = 0.f; }
template <int KS, int MASK>
__device__ __forceinline__ void scores2(const bf16x8 a0, const bf16x8 a1, const bf16x8 qf, float slope2, int dist0, f32x4& z0, f32x4& z1) {
    const f32x4 zero = {0.f, 0.f, 0.f, 0.f};
    const f32x4 s0 = MFMA16(a0, qf, zero), s1 = MFMA16(a1, qf, zero);
#pragma unroll
    for (int r = 0; r < 4; ++r) { const int d0 = dist0 - KS * r, d1 = dist0 - KS * (16 + r);
        float x0 = fmaf(s0[r], ZC, -slope2 * (float)d0), x1 = fmaf(s1[r], ZC, -slope2 * (float)d1);
        if (MASK == 1) { x0 = d0 >= 0 ? x0 : -INFINITY; x1 = d1 >= 0 ? x1 : -INFINITY; }
        if (MASK == 2) { x0 = (d0 >= 0 && d0 < 512) ? x0 : -INFINITY; x1 = (d1 >= 0 && d1 < 512) ? x1 : -INFINITY; }
        z0[r] = x0; z1[r] = x1; }
}
__device__ __forceinline__ void col_update(Col& c, const f32x4 z0, const f32x4 z1, const bf16x8 v0, const bf16x8 v1, int lane) {
    const float tmax = quadall_max(max8(z0, z1), lane);
    const float mn = fmaxf(c.m, tmax), ms = (mn == -INFINITY) ? 0.f : mn;
    const float alpha = ex2(c.m - ms);
    f32x4 p0, p1; float s = 0.f;
#pragma unroll
    for (int r = 0; r < 4; ++r) { p0[r] = ex2(z0[r] - ms); p1[r] = ex2(z1[r] - ms); s += p0[r] + p1[r]; }
    c.l = fmaf(c.l, alpha, s); c.m = mn;
    c.o0 *= alpha; c.o1 *= alpha;
    const bf16x8 pb = pack_p(p0, p1);
    c.o0 = MFMA16(v0, pb, c.o0); c.o1 = MFMA16(v1, pb, c.o1);
}
__device__ __forceinline__ void col_merge(Col& c, float m2, float l2, const f32x4 a0, const f32x4 a1, int quad) {
    const float mn = fmaxf(c.m, m2), ms = (mn == -INFINITY) ? 0.f : mn;
    const float f1 = ex2(c.m - ms), f2 = ex2(m2 - ms);
    c.l = fmaf(c.l, f1, (quad == 0) ? l2 * f2 : 0.f); c.m = mn;
    c.o0 = c.o0 * f1 + a0 * f2; c.o1 = c.o1 * f1 + a1 * f2;
}

template <int K> struct TopK { float v[K]; int i[K]; };
template <int K> __device__ __forceinline__ void topk_init(TopK<K>& t) {
#pragma unroll
    for (int k = 0; k < K; ++k) { t.v[k] = -INFINITY; t.i[k] = -1; } }
template <int K> __device__ __forceinline__ void topk_insert(TopK<K>& t, float v, int idx, bool ok) {
    const bool ins = ok && (v > t.v[K - 1] || (v == t.v[K - 1] && idx < t.i[K - 1]));
    t.v[K - 1] = ins ? v : t.v[K - 1]; t.i[K - 1] = ins ? idx : t.i[K - 1];
#pragma unroll
    for (int k = K - 1; k >= 1; --k) { const bool sw = t.v[k] > t.v[k - 1] || (t.v[k] == t.v[k - 1] && t.i[k] >= 0 && (t.i[k - 1] < 0 || t.i[k] < t.i[k - 1]));
        const float fa = t.v[k], fb = t.v[k - 1]; const int ia = t.i[k], ib = t.i[k - 1];
        t.v[k - 1] = sw ? fa : fb; t.v[k] = sw ? fb : fa; t.i[k - 1] = sw ? ia : ib; t.i[k] = sw ? ib : ia; }
}

constexpr int AW_G = 0;
constexpr int AW_CAND = 16 * 4 * 36 * 4;
constexpr int AW_SEL = AW_CAND + 16 * 20 * 8;
constexpr int AW_BYTES = AW_SEL + 16 * 8 * 4;
static_assert(AW_BYTES * NWAVES <= RING_BYTES, "attention scratch fits the idle GEMM ring");

template <int NSLOT, int NB>
__device__ __forceinline__ void gathered_part(gcb Qrows  , int qcol, gcb KRb, gcb VFb  , LAS unsigned char* wl, int t0, const float slope2, int lane) {
    const int col = lane & 15, quad = lane >> 4, qi = col >> 2, h = col & 3;
    const LAS int* SEL = (const LAS int*)(wl + AW_SEL); LAS float* Gt = (LAS float*)(wl + AW_G);
#pragma unroll 1
    for (int g4 = 0; g4 < 4; ++g4) {
        const int ql = 4 * g4 + qi, tq = t0 + ql;
        const bf16x8 qf = ld8(Qrows + (size_t)tq * 1024 + qcol + h * 32 + quad * 8);
        Col c; col_init(c);
#pragma unroll 1
        for (int slot = 0; slot < NSLOT; ++slot) {
            const int blk = SEL[ql * 8 + slot];
            int bq[4];
#pragma unroll
            for (int k = 0; k < 4; ++k) bq[k] = __builtin_amdgcn_readfirstlane(SEL[(4 * g4 + k) * 8 + slot]);
            if (bq[0] < 0 && bq[1] < 0 && bq[2] < 0 && bq[3] < 0) continue;
#pragma unroll 1
            for (int st = 0; st < NB / 32; ++st) {
                f32x4 z0 = {0.f, 0.f, 0.f, 0.f}, z1 = z0;
#pragma unroll
                for (int k = 0; k < 4; ++k) { const int bb = bq[k] < 0 ? 0 : bq[k]; const size_t key0 = (size_t)bb * NB + 32 * st;
                    const bf16x8 a0 = ld8(KRb + (key0 + col) * 32 + quad * 8), a1 = ld8(KRb + (key0 + 16 + col) * 32 + quad * 8);
                    const f32x4 zero = {0.f, 0.f, 0.f, 0.f};
                    const f32x4 s0 = MFMA16(a0, qf, zero), s1 = MFMA16(a1, qf, zero);
                    if (qi == k) { z0 = s0; z1 = s1; }
                    __builtin_amdgcn_sched_barrier(0); }
                const int dist0 = tq - ((blk < 0 ? 0 : blk) * NB + 32 * st + 4 * quad);
#pragma unroll
                for (int r = 0; r < 4; ++r) { z0[r] = (blk >= 0) ? fmaf(z0[r], ZC, -slope2 * (float)(dist0 - r)) : -INFINITY; z1[r] = (blk >= 0) ? fmaf(z1[r], ZC, -slope2 * (float)(dist0 - 16 - r)) : -INFINITY; }
                const float tmax = quadall_max(max8(z0, z1), lane);
                const float mn = fmaxf(c.m, tmax), ms = (mn == -INFINITY) ? 0.f : mn, alpha = ex2(c.m - ms);
                f32x4 p0, p1; float s = 0.f;
#pragma unroll
                for (int r = 0; r < 4; ++r) { p0[r] = ex2(z0[r] - ms); p1[r] = ex2(z1[r] - ms); s += p0[r] + p1[r]; }
                c.l = fmaf(c.l, alpha, s); c.m = mn; c.o0 *= alpha; c.o1 *= alpha;
                const v4u pw = __builtin_bit_cast(v4u, pack_p(p0, p1));
#pragma unroll
                for (int k = 0; k < 4; ++k) { const int bb = bq[k] < 0 ? 0 : bq[k]; const size_t key0 = (size_t)bb * NB + 32 * st;
                    const bf16x8 vf0 = ld8(VFb + (key0 >> 5) * 1024 + lane * 8), vf1 = ld8(VFb + (key0 >> 5) * 1024 + 512 + lane * 8);
                    const unsigned msk = (qi == k) ? 0xffffffffu : 0u; v4u pm; pm.x = pw.x & msk; pm.y = pw.y & msk; pm.z = pw.z & msk; pm.w = pw.w & msk;
                    const bf16x8 pb = __builtin_bit_cast(bf16x8, pm);
                    c.o0 = MFMA16(vf0, pb, c.o0); c.o1 = MFMA16(vf1, pb, c.o1);
                    __builtin_amdgcn_sched_barrier(0); }
            }
        }
        const float lt = quadall_sum(c.l, lane);
        LAS float* gp = Gt + (ql * 4 + h) * 36;
        if (quad == 0) { gp[0] = c.m; gp[1] = lt; }
        *(LAS f32x4*)(gp + 4 + 4 * quad) = c.o0; *(LAS f32x4*)(gp + 4 + 16 + 4 * quad) = c.o1;
    }
    asm volatile("s_waitcnt lgkmcnt(0)" ::: "memory");
}

__device__ __forceinline__ void nsa_item2(unsigned char* ws_, LAS unsigned char* wl, int b, int tg, int lane) {
    GAS unsigned char* ws = (GAS unsigned char*)ws_;
    gcb QKV = (gcb)(ws + WS_QKV); gb ONSA = (gb)(ws + WS_OCAT) + (size_t)M * 128;
    gcb Qb = QKV + (size_t)b * SEQ * 1024;
    gcb KR = (gcb)(ws + WS_KR) + (size_t)b * SEQ * 32; gcb VF = (gcb)(ws + WS_VF) + (size_t)b * SEQ * 32;
    const int col = lane & 15, quad = lane >> 4, t0 = tg * 16, tq = t0 + col, cur = t0 >> 6;
    constexpr float SL[4] = {LOG2E * 0.5f, LOG2E * 0.125f, LOG2E * 0.03125f, LOG2E * 0.0078125f};
    bf16x8 qf[4];
#pragma unroll
    for (int h = 0; h < 4; ++h) qf[h] = ld8(Qb + (size_t)tq * 1024 + C_NQ + h * 32 + quad * 8);
    GAS float* NACC = (GAS float*)(ws + WS_NACC) + (size_t)(b * SEQ + tq) * 128 + 4 * quad;
#define NSA_GATE(h, k) (1.0f / (1.0f + __expf(-bf1(Qb[(size_t)tq * 1024 + C_NG + (h) * 3 + (k)]))))
    gcb KRc = KR + (size_t)7 * KRV_BR; gcb VFc = VF + (size_t)7 * KRV_BR;
    const int ngr = (t0 + 15 >= 31) ? ((((t0 + 15 - 31) >> 4) + 32) >> 5) : 0;
    float m1[4], l1[4];
#pragma unroll
    for (int h = 0; h < 4; ++h) { m1[h] = -INFINITY; l1[h] = 0.f; }
#pragma unroll 1
    for (int g = 0; g < ngr; ++g) {
        const bf16x8 a0 = ld8(KRc + (size_t)(32 * g + col) * 32 + quad * 8), a1 = ld8(KRc + (size_t)(32 * g + 16 + col) * 32 + quad * 8);
        const int dist0 = tq - 31 - 16 * (32 * g + 4 * quad);
#pragma unroll
        for (int h = 0; h < 4; ++h) { f32x4 z0, z1; scores2<16, 1>(a0, a1, qf[h], SL[h], dist0, z0, z1);
            const float tmax = quadall_max(max8(z0, z1), lane); const float mn = fmaxf(m1[h], tmax), ms = (mn == -INFINITY) ? 0.f : mn;
            float s = 0.f;
#pragma unroll
            for (int r = 0; r < 4; ++r) s += ex2(z0[r] - ms) + ex2(z1[r] - ms);
            l1[h] = fmaf(l1[h], ex2(m1[h] - ms), s); m1[h] = mn; }
    }
    float il[4];
#pragma unroll
    for (int h = 0; h < 4; ++h) { const float lt = quadall_sum(l1[h], lane); il[h] = lt > 0.f ? 1.0f / lt : 0.f; m1[h] = (m1[h] == -INFINITY) ? 0.f : m1[h]; }
    TopK<5> tk; topk_init(tk);
    f32x4 oc0[4], oc1[4];
#pragma unroll
    for (int h = 0; h < 4; ++h) { oc0[h] = (f32x4){0.f, 0.f, 0.f, 0.f}; oc1[h] = oc0[h]; }
    float tail_carry = 0.f;
#pragma unroll 1
    for (int g = 0; g < ngr; ++g) {
        const bf16x8 a0 = ld8(KRc + (size_t)(32 * g + col) * 32 + quad * 8), a1 = ld8(KRc + (size_t)(32 * g + 16 + col) * 32 + quad * 8);
        const bf16x8 v0 = ld8(VFc + (size_t)g * 1024 + lane * 8), v1 = ld8(VFc + (size_t)g * 1024 + 512 + lane * 8);
        const int dist0 = tq - 31 - 16 * (32 * g + 4 * quad);
        f32x4 ps0 = {0.f, 0.f, 0.f, 0.f}, ps1 = ps0;
#pragma unroll
        for (int h = 0; h < 4; ++h) { f32x4 z0, z1; scores2<16, 1>(a0, a1, qf[h], SL[h], dist0, z0, z1);
            f32x4 p0, p1;
#pragma unroll
            for (int r = 0; r < 4; ++r) { p0[r] = ex2(z0[r] - m1[h]) * il[h]; p1[r] = ex2(z1[r] - m1[h]) * il[h]; }
            ps0 += p0; ps1 += p1;
            const bf16x8 pb = pack_p(p0, p1);
            oc0[h] = MFMA16(v0, pb, oc0[h]); oc1[h] = MFMA16(v1, pb, oc1[h]); __builtin_amdgcn_sched_barrier(0); }
        const float t0s = ps0[3], t1s = ps1[3];
        const float pv0 = shx(t0s, (quad == 0) ? 0 : 16 * ((quad - 1) ^ quad), lane);
        const float pv1 = shx(t1s, (quad == 0) ? 0 : 16 * ((quad - 1) ^ quad), lane);
        const float q3t0 = shx(t0s, 16 * (quad ^ 3), lane);
        const float q3t1 = shx(t1s, 16 * (quad ^ 3), lane);
        const float prev0 = (quad == 0) ? tail_carry : pv0, prev1 = (quad == 0) ? q3t0 : pv1;
        const float imp0 = prev0 + 2.0f * (ps0[0] + ps0[1] + ps0[2]) + ps0[3], imp1 = prev1 + 2.0f * (ps1[0] + ps1[1] + ps1[2]) + ps1[3];
        tail_carry = q3t1;
        const int j0 = 8 * g + quad, j1 = 8 * g + 4 + quad;
        topk_insert(tk, imp0, j0, j0 >= 1 && j0 <= cur - 2);
        topk_insert(tk, imp1, j1, j1 >= 1 && j1 <= cur - 2);
    }
#pragma unroll
    for (int h = 0; h < 4; ++h) { const float g0 = NSA_GATE(h, 0); *(GAS f32x4*)(NACC + h * 32) = oc0[h] * g0; *(GAS f32x4*)(NACC + h * 32 + 16) = oc1[h] * g0; }
    {
        LAS float* CV = (LAS float*)(wl + AW_CAND); LAS int* CI = (LAS int*)(wl + AW_CAND) + 1; LAS int* SEL = (LAS int*)(wl + AW_SEL);
#pragma unroll
        for (int k = 0; k < 5; ++k) { CV[((col * 4 + quad) * 5 + k) * 2] = tk.v[k]; CI[((col * 4 + quad) * 5 + k) * 2] = tk.i[k]; }
        asm volatile("s_waitcnt lgkmcnt(0)" ::: "memory");
        if (quad == 0) { TopK<5> fin; topk_init(fin);
            for (int e = 0; e < 20; ++e) { const float v = CV[(col * 20 + e) * 2]; const int i = CI[(col * 20 + e) * 2]; topk_insert(fin, v, i, i >= 0); }
#pragma unroll
            for (int k = 0; k < 5; ++k) SEL[col * 8 + k] = fin.i[k];
            int neg1; asm volatile("v_mov_b32 %0, -1" : "=v"(neg1));
            SEL[col * 8 + 5] = neg1; SEL[col * 8 + 6] = neg1; SEL[col * 8 + 7] = neg1; }
        asm volatile("s_waitcnt lgkmcnt(0)" ::: "memory");
    }
    gathered_part<5, 64>(Qb, C_NQ, KR + (size_t)1 * KRV_BR, VF + (size_t)1 * KRV_BR, wl, t0, LOG2E * ((lane & 3) == 0 ? 0.5f : (lane & 3) == 1 ? 0.125f : (lane & 3) == 2 ? 0.03125f : 0.0078125f), lane);
    {
        gcb KRs = KR + (size_t)1 * KRV_BR; gcb VFs = VF + (size_t)1 * KRV_BR;
        Col c[4];
#pragma unroll
        for (int h = 0; h < 4; ++h) col_init(c[h]);
#pragma unroll 1
        for (int f = 0; f < 3; ++f) {
            const int blk = f == 0 ? 0 : f == 1 ? (cur >= 2 ? cur - 1 : -1) : (cur >= 1 ? cur : -1);
            if (blk < 0) continue;
#pragma unroll 1
            for (int st = 0; st < 2; ++st) { const int key0 = blk * 64 + 32 * st;
                const bf16x8 a0 = ld8(KRs + (size_t)(key0 + col) * 32 + quad * 8), a1 = ld8(KRs + (size_t)(key0 + 16 + col) * 32 + quad * 8);
                const bf16x8 v0 = ld8(VFs + (size_t)(key0 >> 5) * 1024 + lane * 8), v1 = ld8(VFs + (size_t)(key0 >> 5) * 1024 + 512 + lane * 8);
                const int dist0 = tq - (key0 + 4 * quad);
#pragma unroll
                for (int h = 0; h < 4; ++h) { f32x4 z0, z1; scores2<1, 1>(a0, a1, qf[h], SL[h], dist0, z0, z1); col_update(c[h], z0, z1, v0, v1, lane); __builtin_amdgcn_sched_barrier(0); } }
        }
        const LAS float* Gt = (const LAS float*)(wl + AW_G);
#pragma unroll
        for (int h = 0; h < 4; ++h) { const LAS float* gp = Gt + (col * 4 + h) * 36;
            col_merge(c[h], gp[0], gp[1], *(const LAS f32x4*)(gp + 4 + 4 * quad), *(const LAS f32x4*)(gp + 4 + 16 + 4 * quad), quad);
            const float f = NSA_GATE(h, 1) / quadall_sum(c[h].l, lane);
            *(GAS f32x4*)(NACC + h * 32) += c[h].o0 * f; *(GAS f32x4*)(NACC + h * 32 + 16) += c[h].o1 * f; }
    }
    {
        gcb KRw = KR; gcb VFw = VF;
        Col c[4];
#pragma unroll
        for (int h = 0; h < 4; ++h) col_init(c[h]);
        const int g_lo = (t0 - 511 > 0) ? ((t0 - 511) >> 5) : 0, g_hi = (t0 + 15) >> 5;
#pragma unroll 1
        for (int g = g_lo; g <= g_hi; ++g) { const int key0 = 32 * g;
            const bf16x8 a0 = ld8(KRw + (size_t)(key0 + col) * 32 + quad * 8), a1 = ld8(KRw + (size_t)(key0 + 16 + col) * 32 + quad * 8);
            const bf16x8 v0 = ld8(VFw + (size_t)g * 1024 + lane * 8), v1 = ld8(VFw + (size_t)g * 1024 + 512 + lane * 8);
            const int dist0 = tq - (key0 + 4 * quad);
#pragma unroll
            for (int h = 0; h < 4; ++h) { f32x4 z0, z1; scores2<1, 2>(a0, a1, qf[h], SL[h], dist0, z0, z1); col_update(c[h], z0, z1, v0, v1, lane); __builtin_amdgcn_sched_barrier(0); }
        }
#pragma unroll
        for (int h = 0; h < 4; ++h) { const float f = NSA_GATE(h, 2) / quadall_sum(c[h].l, lane);
            const f32x4 x0 = *(GAS f32x4*)(NACC + h * 32) + c[h].o0 * f, x1 = *(GAS f32x4*)(NACC + h * 32 + 16) + c[h].o1 * f;
            gb op = ONSA + (size_t)(b * SEQ + tq) * 128 + h * 32 + 4 * quad;
            u32x2 w0, w1; w0.x = cvtpk(x0[0], x0[1]); w0.y = cvtpk(x0[2], x0[3]); w1.x = cvtpk(x1[0], x1[1]); w1.y = cvtpk(x1[2], x1[3]);
            *(GAS u32x2*)op = w0; *(GAS u32x2*)(op + 16) = w1; }
    }
}

__device__ __forceinline__ void moba_item2(unsigned char* ws_, LAS unsigned char* wl, int b, int tg, int lane) {
    GAS unsigned char* ws = (GAS unsigned char*)ws_;
    gcb QKV = (gcb)(ws + WS_QKV); gb OMB = (gb)(ws + WS_OCAT) + (size_t)2 * M * 128;
    gcb Qb = QKV + (size_t)b * SEQ * 1024;
    gcb KRm = (gcb)(ws + WS_KR) + (size_t)2 * KRV_BR + (size_t)b * SEQ * 32; gcb VFm = (gcb)(ws + WS_VF) + (size_t)2 * KRV_BR + (size_t)b * SEQ * 32;
    const int col = lane & 15, quad = lane >> 4, t0 = tg * 16, tq = t0 + col, cur = t0 >> 8;
    constexpr float SL[4] = {LOG2E * 0.25f, LOG2E * 0.0625f, LOG2E * 0.015625f, LOG2E * 0.00390625f};
    bf16x8 qf[4];
#pragma unroll
    for (int h = 0; h < 4; ++h) qf[h] = ld8(Qb + (size_t)tq * 1024 + C_MQ + h * 32 + quad * 8);
    {
        gcb KMH = (gcb)(ws + WS_KMH) + (size_t)b * 64 * 32; gcb KML = (gcb)(ws + WS_KML) + (size_t)b * 64 * 32;
        TopK<3> tk; topk_init(tk);
        const int nt = (cur + 15) >> 4;
#pragma unroll 1
        for (int T = 0; T < nt; ++T) {
            const bf16x8 ah = ld8(KMH + (size_t)(16 * T + col) * 32 + quad * 8), al = ld8(KML + (size_t)(16 * T + col) * 32 + quad * 8);
            f32x4 s = {0.f, 0.f, 0.f, 0.f};
#pragma unroll
            for (int h = 0; h < 4; ++h) { s = MFMA16(ah, qf[h], s); s = MFMA16(al, qf[h], s); }
#pragma unroll
            for (int r = 0; r < 4; ++r) { const int n = 16 * T + 4 * quad + r; topk_insert(tk, s[r], n, n < cur); }
        }
        LAS float* CV = (LAS float*)(wl + AW_CAND); LAS int* CI = (LAS int*)(wl + AW_CAND) + 1; LAS int* SEL = (LAS int*)(wl + AW_SEL);
#pragma unroll
        for (int k = 0; k < 3; ++k) { CV[((col * 4 + quad) * 3 + k) * 2] = tk.v[k]; CI[((col * 4 + quad) * 3 + k) * 2] = tk.i[k]; }
        asm volatile("s_waitcnt lgkmcnt(0)" ::: "memory");
        if (quad == 0) { TopK<3> fin; topk_init(fin);
            for (int e = 0; e < 12; ++e) { const float v = CV[(col * 12 + e) * 2]; const int i = CI[(col * 12 + e) * 2]; topk_insert(fin, v, i, i >= 0); }
#pragma unroll
            for (int k = 0; k < 3; ++k) SEL[col * 8 + k] = fin.i[k]; }
        asm volatile("s_waitcnt lgkmcnt(0)" ::: "memory");
    }
    gathered_part<3, 256>(Qb, C_MQ, KRm, VFm, wl, t0, LOG2E * ((lane & 3) == 0 ? 0.25f : (lane & 3) == 1 ? 0.0625f : (lane & 3) == 2 ? 0.015625f : 0.00390625f), lane);
    Col c[4];
#pragma unroll
    for (int h = 0; h < 4; ++h) col_init(c[h]);
    const int g_hi = (t0 + 15) >> 5;
#pragma unroll 1
    for (int g = cur * 8; g <= g_hi; ++g) { const int key0 = 32 * g;
        const bf16x8 a0 = ld8(KRm + (size_t)(key0 + col) * 32 + quad * 8), a1 = ld8(KRm + (size_t)(key0 + 16 + col) * 32 + quad * 8);
        const bf16x8 v0 = ld8(VFm + (size_t)g * 1024 + lane * 8), v1 = ld8(VFm + (size_t)g * 1024 + 512 + lane * 8);
        const int dist0 = tq - (key0 + 4 * quad);
#pragma unroll
        for (int h = 0; h < 4; ++h) { f32x4 z0, z1; scores2<1, 1>(a0, a1, qf[h], SL[h], dist0, z0, z1); col_update(c[h], z0, z1, v0, v1, lane); __builtin_amdgcn_sched_barrier(0); }
    }
    const LAS float* Gt = (const LAS float*)(wl + AW_G);
#pragma unroll
    for (int h = 0; h < 4; ++h) { const LAS float* gp = Gt + (col * 4 + h) * 36;
        col_merge(c[h], gp[0], gp[1], *(const LAS f32x4*)(gp + 4 + 4 * quad), *(const LAS f32x4*)(gp + 4 + 16 + 4 * quad), quad);
        const float f = 1.0f / quadall_sum(c[h].l, lane);
        const f32x4 x0 = c[h].o0 * f, x1 = c[h].o1 * f;
        gb op = OMB + (size_t)(b * SEQ + tq) * 128 + h * 32 + 4 * quad;
        u32x2 w0, w1; w0.x = cvtpk(x0[0], x0[1]); w0.y = cvtpk(x0[2], x0[3]); w1.x = cvtpk(x1[0], x1[1]); w1.y = cvtpk(x1[2], x1[3]);
        *(GAS u32x2*)op = w0; *(GAS u32x2*)(op + 16) = w1; }
}

__device__ __forceinline__ void sb_item2(unsigned char* ws_, int item, int lane) {
    GAS unsigned char* ws = (GAS unsigned char*)ws_;
    gcb QKV = (gcb)(ws + WS_QKV); gb OSB = (gb)(ws + WS_OCAT);
    const int b = item >> 12, h = (item >> 10) & 3, tg = item & 1023, t0 = tg * 16;
    const int col = lane & 15, quad = lane >> 4, tq = t0 + col;
    gcb KRh = (gcb)(ws + WS_KR) + (size_t)(3 + h) * KRV_BR + (size_t)b * SEQ * 32; gcb VFh = (gcb)(ws + WS_VF) + (size_t)(3 + h) * KRV_BR + (size_t)b * SEQ * 32;
    const bf16x8 qf = ld8(QKV + (size_t)(b * SEQ + tq) * 1024 + C_SBQ + h * 32 + quad * 8);
    f32x4 o0 = {0.f, 0.f, 0.f, 0.f}, o1 = o0; float carry = 0.f;
#pragma unroll 1
    for (int g = (t0 + 15) >> 5; g >= 0; --g) { const int key0 = 32 * g;
        const bf16x8 a0 = ld8(KRh + (size_t)(key0 + col) * 32 + quad * 8), a1 = ld8(KRh + (size_t)(key0 + 16 + col) * 32 + quad * 8);
        const bf16x8 v0 = ld8(VFh + (size_t)g * 1024 + lane * 8), v1 = ld8(VFh + (size_t)g * 1024 + 512 + lane * 8);
        const f32x4 zero = {0.f, 0.f, 0.f, 0.f};
        const f32x4 s0 = MFMA16(a0, qf, zero), s1 = MFMA16(a1, qf, zero);
        const int dist0 = tq - (key0 + 4 * quad);
        f32x4 z0, z1, ls0, ls1;
#pragma unroll
        for (int r = 0; r < 4; ++r) {
            const float x0 = s0[r] * ZC, x1 = s1[r] * ZC;
            const float sp0 = fmaxf(x0, 0.f) + lg2(1.0f + ex2(-fabsf(x0))), sp1 = fmaxf(x1, 0.f) + lg2(1.0f + ex2(-fabsf(x1)));
            const bool v0p = dist0 - r > 0, v1p = dist0 - 16 - r > 0;
            z0[r] = v0p ? x0 - sp0 : -INFINITY; z1[r] = v1p ? x1 - sp1 : -INFINITY; ls0[r] = v0p ? -sp0 : 0.f; ls1[r] = v1p ? -sp1 : 0.f; }
        const float G0 = (ls0[0] + ls0[1]) + (ls0[2] + ls0[3]), G1 = (ls1[0] + ls1[1]) + (ls1[2] + ls1[3]);
        const float a10 = shx(G0, 16, lane), a20 = shx(G0, 32, lane), a30 = shx(a10, 32, lane);
        const float a11 = shx(G1, 16, lane), a21 = shx(G1, 32, lane), a31 = shx(a11, 32, lane);
        const float hi0 = ((quad ^ 1) > quad ? a10 : 0.f) + ((quad ^ 2) > quad ? a20 : 0.f) + ((quad ^ 3) > quad ? a30 : 0.f);
        const float hi1 = ((quad ^ 1) > quad ? a11 : 0.f) + ((quad ^ 2) > quad ? a21 : 0.f) + ((quad ^ 3) > quad ? a31 : 0.f);
        const float tot0 = (G0 + a10) + (a20 + a30), tot1 = (G1 + a11) + (a21 + a31);
        const float e1 = carry + hi1, e0 = carry + tot1 + hi0;
        f32x4 p0, p1;
        p1[3] = ex2(z1[3] + e1); p1[2] = ex2(z1[2] + e1 + ls1[3]); p1[1] = ex2(z1[1] + e1 + (ls1[3] + ls1[2])); p1[0] = ex2(z1[0] + e1 + ((ls1[3] + ls1[2]) + ls1[1]));
        p0[3] = ex2(z0[3] + e0); p0[2] = ex2(z0[2] + e0 + ls0[3]); p0[1] = ex2(z0[1] + e0 + (ls0[3] + ls0[2])); p0[0] = ex2(z0[0] + e0 + ((ls0[3] + ls0[2]) + ls0[1]));
        carry += tot0 + tot1;
        const bf16x8 pb = pack_p(p0, p1);
        o0 = MFMA16(v0, pb, o0); o1 = MFMA16(v1, pb, o1);
        if (__all(carry < -151.0f)) break;
    }
    gb op = OSB + (size_t)(b * SEQ + tq) * 128 + h * 32 + 4 * quad;
    u32x2 w0, w1; w0.x = cvtpk(o0[0], o0[1]); w0.y = cvtpk(o0[2], o0[3]); w1.x = cvtpk(o1[0], o1[1]); w1.y = cvtpk(o1[2], o1[3]);
    *(GAS u32x2*)op = w0; *(GAS u32x2*)(op + 16) = w1;
}

__device__ __forceinline__ void attn_phase2(unsigned char* ws_, LAS unsigned char* lds, int vcu, int wave) {
    unsigned char* ws = opq_ptr(ws_);
    const int lane = lane_id();
    LAS unsigned char* wl = lds + RING_OFF + wave * AW_BYTES;
#ifdef NSA_SIMPLE
    { const int k = vcu * 4 + (wave & 3); if (wave < 4) nsa_item(ws, 0, k, lane); else nsa_item(ws, 1, 1023 - k, lane); }
#elif !defined(NO_NSA2)
    { const int k = vcu * 4 + (wave & 3); nsa_item2(ws, wl, wave < 4 ? 0 : 1, wave < 4 ? k : 1023 - k, lane); }
#endif
#ifdef MOBA_SIMPLE
    { const int it = vcu * 8 + wave; moba_item(ws, it >> 10, it & 1023, lane); }
#elif !defined(NO_MOBA2)
    { const int it = vcu * 8 + wave; moba_item2(ws, wl, it >> 10, it & 1023, lane); }
#endif
#ifdef SB_SIMPLE
    sb_item(ws, vcu * 8 + wave, lane);
#elif !defined(NO_SB2)
#pragma unroll 1
    for (int k = 0; k < 4; ++k) sb_item2(ws, (vcu * 8 + wave) + 2048 * k, lane);
#endif
}

__device__ __forceinline__ void ln_row(const float* y16, const float* g, const float* bta, int lane, float* o16) {
    float s = 0.f;
#pragma unroll
    for (int i = 0; i < 16; ++i) s += y16[i];
    const float mean = wave_sum(s, lane) * (1.0f / D); float s2 = 0.f;
#pragma unroll
    for (int i = 0; i < 16; ++i) { const float dd = y16[i] - mean; s2 = fmaf(dd, dd, s2); }
    const float rstd = 1.0f / sqrtf(wave_sum(s2, lane) * (1.0f / D) + LN_EPS);
#pragma unroll
    for (int hh = 0; hh < 2; ++hh)
#pragma unroll
        for (int i = 0; i < 8; ++i) { const int c = hh * 512 + lane * 8 + i; o16[hh * 8 + i] = (y16[hh * 8 + i] - mean) * rstd * g[c] + bta[c]; }
}
__device__ __forceinline__ void load_row16(const float* row, int lane, float* v) {
#pragma unroll
    for (int hh = 0; hh < 2; ++hh) { const f32x4 a = *(const f32x4*)(row + hh * 512 + lane * 8), b = *(const f32x4*)(row + hh * 512 + lane * 8 + 4);
        v[hh * 8 + 0] = a.x; v[hh * 8 + 1] = a.y; v[hh * 8 + 2] = a.z; v[hh * 8 + 3] = a.w; v[hh * 8 + 4] = b.x; v[hh * 8 + 5] = b.y; v[hh * 8 + 6] = b.z; v[hh * 8 + 7] = b.w; }
}
__device__ __forceinline__ void store_row16(float* row, bf16* rowb, int lane, const float* v) {
#pragma unroll
    for (int hh = 0; hh < 2; ++hh) {
        *(f32x4*)(row + hh * 512 + lane * 8) = (f32x4){v[hh * 8], v[hh * 8 + 1], v[hh * 8 + 2], v[hh * 8 + 3]};
        *(f32x4*)(row + hh * 512 + lane * 8 + 4) = (f32x4){v[hh * 8 + 4], v[hh * 8 + 5], v[hh * 8 + 6], v[hh * 8 + 7]};
        if (rowb) { v4u w; w.x = pk2(v[hh * 8], v[hh * 8 + 1]); w.y = pk2(v[hh * 8 + 2], v[hh * 8 + 3]); w.z = pk2(v[hh * 8 + 4], v[hh * 8 + 5]); w.w = pk2(v[hh * 8 + 6], v[hh * 8 + 7]);
            *(v4u*)(rowb + hh * 512 + lane * 8) = w; }
    }
}
__device__ __forceinline__ void ln1_phase(const Ptrs& A, int l, int vcu, int NGW, int wave) {
    const int lane = lane_id(), gw = vcu * NWAVES + wave;
    unsigned char* ws = opq_ptr(A.ws); const float* Y = (const float*)(ws + WS_Y); float* X1 = (float*)(ws + WS_X1); bf16* X1B = (bf16*)(ws + WS_XB);
    const float* g = A.in[10] + (size_t)l * D; const float* bt = A.in[11] + (size_t)l * D;
    for (int m = gw; m < M; m += NGW) { float y[16], o[16]; load_row16(Y + (size_t)m * D, lane, y); ln_row(y, g, bt, lane, o); store_row16(X1 + (size_t)m * D, X1B + (size_t)m * D, lane, o); }
}

__device__ __forceinline__ float gelu_tanh(float x) {
    const float u = 0.7978845608028654f * (x + 0.044715f * x * x * x);
    const float e = __expf(-2.0f * fabsf(u)); const float th = (1.0f - e) / (1.0f + e);
    return 0.5f * x * (1.0f + (u < 0.f ? -th : th));
}
__device__ __forceinline__ void peer_wave(const Ptrs& A, int l, int vcu, bool last, int wave) {
    const int lane = lane_id(), tok0 = (vcu * NWAVES + wave) * 16;
    unsigned char* ws = opq_ptr(A.ws);
    const bf16* QP = (const bf16*)(ws + WS_QP); const bf16* PK = (const bf16*)(ws + WS_PK) + (size_t)l * 4 * 2 * 16384;
    const unsigned char* UQ = ws + WS_UQ + (size_t)l * NEXP * D; const unsigned char* VQ = ws + WS_VQ + (size_t)l * NEXP * D;
    const float* US = (const float*)(ws + WS_US) + (size_t)l * NEXP; const float* VS = (const float*)(ws + WS_VS) + (size_t)l * NEXP;
    const int lz = lane_zero();
    const float* X1 = (const float*)(ws + WS_X1);
    float* Xout = last ? A.out : (float*)(ws + WS_X); bf16* XBout = last ? nullptr : (bf16*)(ws + WS_XB);
    const int col = lane & 15, qd = lane >> 4;
    float mytop[8]; int myidx[8];
#pragma unroll
    for (int i = 0; i < 8; ++i) { mytop[i] = 0.f; myidx[i] = 0; }
#pragma unroll 1
    for (int h = 0; h < 4; ++h) {
        float v12[2][8]; int i12[2][8];
#pragma unroll
        for (int half = 0; half < 2; ++half) {
            f32x4 sc[8];
#pragma unroll
            for (int kt = 0; kt < 8; ++kt) sc[kt] = (f32x4){0.f, 0.f, 0.f, 0.f};
            const bf16* kp = PK + (size_t)(h * 2 + half) * 16384 + (size_t)col * 128 + qd * 8;
            const bf16* qp = QP + (size_t)(tok0 + col) * 1024 + h * 256 + half * 128 + qd * 8;
#pragma unroll
            for (int ks = 0; ks < 4; ++ks) { const bf16x8 bq = __builtin_bit_cast(bf16x8, *(const v4u*)(qp + ks * 32));
#pragma unroll
                for (int kt = 0; kt < 8; ++kt) { const bf16x8 ak = __builtin_bit_cast(bf16x8, *(const v4u*)(kp + (size_t)kt * 16 * 128 + ks * 32));
                    sc[kt] = __builtin_amdgcn_mfma_f32_16x16x32_bf16(ak, bq, sc[kt], 0, 0, 0); } }
#pragma unroll
            for (int r8 = 0; r8 < 8; ++r8) {
                float best = -INFINITY; int bi = 0x7fffffff;
#pragma unroll
                for (int kt = 0; kt < 8; ++kt)
#pragma unroll
                    for (int rr = 0; rr < 4; ++rr) { const float v = sc[kt][rr]; const bool tk = v > best; best = tk ? v : best; bi = tk ? (kt * 16 + 4 * qd + rr) : bi; }
#pragma unroll
                for (int off = 16; off <= 32; off <<= 1) { const float ov = shx(best, off, lane); const int oi = shxi(bi, off, lane);
                    const bool tk = (ov > best) || (ov == best && oi < bi); best = tk ? ov : best; bi = tk ? oi : bi; }
                v12[half][r8] = best; i12[half][r8] = bi;
#pragma unroll
                for (int kt = 0; kt < 8; ++kt)
#pragma unroll
                    for (int rr = 0; rr < 4; ++rr) sc[kt][rr] = ((kt * 16 + 4 * qd + rr) == bi) ? -INFINITY : sc[kt][rr];
            }
        }
        float cv[20]; int ce[20];
        {
            constexpr int A20[20] = {0, 0, 0, 0, 0, 0, 0, 0, 1, 1, 1, 1, 2, 2, 3, 3, 4, 5, 6, 7}, B20[20] = {0, 1, 2, 3, 4, 5, 6, 7, 0, 1, 2, 3, 0, 1, 0, 1, 0, 0, 0, 0};
#pragma unroll
            for (int e = 0; e < 20; ++e) { cv[e] = v12[0][A20[e]] + v12[1][B20[e]]; ce[e] = i12[0][A20[e]] * 128 + i12[1][B20[e]]; }
        }
#pragma unroll
        for (int r8 = 0; r8 < 8; ++r8) {
            float best = -INFINITY; int be = 0, bx = -1;
#pragma unroll
            for (int e = 0; e < 20; ++e) { const bool tk = cv[e] > best; best = tk ? cv[e] : best; be = tk ? ce[e] : be; bx = tk ? e : bx; }
#pragma unroll
            for (int e = 0; e < 20; ++e) cv[e] = (e == bx) ? -INFINITY : cv[e];
            if (qd == h) { mytop[r8] = best; myidx[r8] = be; }
        }
    }
    float myg[8];
    { float s = 0.f;
#pragma unroll
      for (int i = 0; i < 8; ++i) { myg[i] = __expf(mytop[i] - mytop[0]); s += myg[i]; }
      const float is = 1.0f / s;
#pragma unroll
      for (int i = 0; i < 8; ++i) myg[i] *= is; }
    const float* g2 = A.in[17] + (size_t)l * D; const float* b2 = A.in[18] + (size_t)l * D;
#pragma unroll 1
    for (int tt = 0; tt < 16; ++tt) {
        const int tok = tok0 + tt;
        float xr[16], outv[16];
        load_row16(X1 + (size_t)tok * D, lane, xr);
        float sx = 0.f;
#pragma unroll
        for (int i = 0; i < 16; ++i) { outv[i] = 0.f; sx += xr[i]; }
        const float SX128 = 128.0f * wave_sum(sx, lane);
        float wsum = 0.f;
#pragma unroll 1
        for (int h = 0; h < 4; ++h) {
            const int src = tt + 16 * h; float dp[8], sc[8]; int ex[8];
#pragma unroll
            for (int e = 0; e < 8; ++e) {
                ex[e] = __builtin_amdgcn_readlane(myidx[e], src);
                const v4u a = *(const v4u*)(UQ + (size_t)ex[e] * D + 16 * lane);
                sc[e] = US[ex[e] + lz];
                float s = 0.f;
                s = fmaf((float)(a.x & 255u), xr[0], s); s = fmaf((float)((a.x >> 8) & 255u), xr[1], s); s = fmaf((float)((a.x >> 16) & 255u), xr[2], s); s = fmaf((float)(a.x >> 24), xr[3], s);
                s = fmaf((float)(a.y & 255u), xr[4], s); s = fmaf((float)((a.y >> 8) & 255u), xr[5], s); s = fmaf((float)((a.y >> 16) & 255u), xr[6], s); s = fmaf((float)(a.y >> 24), xr[7], s);
                s = fmaf((float)(a.z & 255u), xr[8], s); s = fmaf((float)((a.z >> 8) & 255u), xr[9], s); s = fmaf((float)((a.z >> 16) & 255u), xr[10], s); s = fmaf((float)(a.z >> 24), xr[11], s);
                s = fmaf((float)(a.w & 255u), xr[12], s); s = fmaf((float)((a.w >> 8) & 255u), xr[13], s); s = fmaf((float)((a.w >> 16) & 255u), xr[14], s); s = fmaf((float)(a.w >> 24), xr[15], s);
                dp[e] = s;
            }
#pragma unroll
            for (int e = 0; e < 8; ++e) dp[e] = (wave_sum(dp[e], lane) - SX128) * sc[e];
#pragma unroll
            for (int e = 0; e < 8; ++e) {
                const float gg = __int_as_float(__builtin_amdgcn_readlane(__float_as_int(myg[e]), src));
                const float w = gg * gelu_tanh(dp[e]) * VS[ex[e] + lz];
                wsum += w;
                const v4u a = *(const v4u*)(VQ + (size_t)ex[e] * D + 16 * lane);
                outv[0] = fmaf(w, (float)(a.x & 255u), outv[0]); outv[1] = fmaf(w, (float)((a.x >> 8) & 255u), outv[1]); outv[2] = fmaf(w, (float)((a.x >> 16) & 255u), outv[2]); outv[3] = fmaf(w, (float)(a.x >> 24), outv[3]);
                outv[4] = fmaf(w, (float)(a.y & 255u), outv[4]); outv[5] = fmaf(w, (float)((a.y >> 8) & 255u), outv[5]); outv[6] = fmaf(w, (float)((a.y >> 16) & 255u), outv[6]); outv[7] = fmaf(w, (float)(a.y >> 24), outv[7]);
                outv[8] = fmaf(w, (float)(a.z & 255u), outv[8]); outv[9] = fmaf(w, (float)((a.z >> 8) & 255u), outv[9]); outv[10] = fmaf(w, (float)((a.z >> 16) & 255u), outv[10]); outv[11] = fmaf(w, (float)(a.z >> 24), outv[11]);
                outv[12] = fmaf(w, (float)(a.w & 255u), outv[12]); outv[13] = fmaf(w, (float)((a.w >> 8) & 255u), outv[13]); outv[14] = fmaf(w, (float)((a.w >> 16) & 255u), outv[14]); outv[15] = fmaf(w, (float)(a.w >> 24), outv[15]);
            }
        }
        { const float corr = 128.0f * wsum;
#pragma unroll
          for (int i = 0; i < 16; ++i) outv[i] -= corr; }
        float y[16], o[16];
#pragma unroll
        for (int i = 0; i < 16; ++i) y[i] = fmaf(ALPHA, xr[i], outv[i]);
        ln_row(y, g2, b2, lane, o);
        store_row16(Xout + (size_t)tok * D, XBout ? XBout + (size_t)tok * D : nullptr, lane, o);
    }
}

#ifndef REP_ATTN
#define REP_ATTN 1
#endif
#ifndef REP_PEER
#define REP_PEER 1
#endif
#ifndef REP_GEMM
#define REP_GEMM 1
#endif
#ifndef REP_PREP
#define REP_PREP 1
#endif
__global__ void __launch_bounds__(NWAVES * 64, 2) hybrid_fwd(Ptrs A) {
    extern __shared__ __attribute__((aligned(16))) unsigned char lds_raw[];
    LAS unsigned char* lds = (LAS unsigned char*)lds_raw;
    volatile LAS unsigned* MISC = (volatile LAS unsigned*)(lds + MISC_OFF);
    const int G = gridDim.x, bx = blockIdx.x, vcu = (G % 8 == 0) ? (bx % 8) * (G / 8) + bx / 8 : bx, NGW = G * NWAVES;
    const int wave = __builtin_amdgcn_readfirstlane(threadIdx.x >> 6);
#define LEADER() (opq(wave) == 0 && lane_id() == 0)
    for (int u = wave * 64 + lane_id(); u < (LDS_BYTES - LDSCTL_OFF) / 4; u += NWAVES * 64) ((LAS unsigned*)(lds + LDSCTL_OFF))[u] = 0u;
    __syncthreads();
    XcdBarrier bar = xcd_barrier_post((unsigned*)(A.ws + WS_CTL) + CW_BAR, MISC + 8, LEADER());

#ifndef NO_PRO
    prologue(A, lds, opq(vcu), NGW, opq(wave));
#endif
    xcd_barrier(bar, LEADER());

#pragma unroll 1
    for (int l = 0; l < DEPTH; ++l) {
#ifndef NO_G1
        _Pragma("unroll 1") for (int rep = 0; rep < REP_GEMM; ++rep)
        { unsigned char* ws = opq_ptr(A.ws); const pg8::bf16_t* XB = (const pg8::bf16_t*)(ws + WS_XB);
          pg8::Gemm g{XB, (const pg8::bf16_t*)(ws + WS_WQKV) + (size_t)l * 1024 * 1024, M, 1024, D}; pg8::StaticOrder S; S.init(M, 1024, opq(G), opq(bx));
          pg8::EpiBf16<0> E{(pg8::bf16_t*)(ws + WS_QKV), 1024, nullptr, 0, 0, 1.f};
          pg8::gemm_phase<pg8::EpiBf16<0>, pg8::StaticOrder, true, true>(lds + RING_OFF, g, S, E, opq(wave)); }
#endif
        xcd_barrier(bar, LEADER());
#if defined(NSA_SIMPLE) || defined(MOBA_SIMPLE) || defined(SB_SIMPLE)
        prep_phase(A, l, opq(vcu), NGW, opq(wave));
#endif
        _Pragma("unroll 1") for (int rep = 0; rep < REP_PREP; ++rep)
        prep2_phase(A, lds, l, opq(vcu), NGW, opq(wave));
        xcd_barrier(bar, LEADER());
#ifndef NO_ATTN
        _Pragma("unroll 1") for (int rep = 0; rep < REP_ATTN; ++rep)
        if (opq(G) == 256) attn_phase2(A.ws, lds, opq(vcu), opq(wave));
#endif
        xcd_barrier(bar, LEADER());
#ifndef NO_G2
        _Pragma("unroll 1") for (int rep = 0; rep < REP_GEMM; ++rep)
        { unsigned char* ws = opq_ptr(A.ws);
          pg8::Gemm g{(const pg8::bf16_t*)(ws + WS_OCAT), (const pg8::bf16_t*)(ws + WS_WBR) + (size_t)l * 3 * 1024 * 128, 3 * M, 3 * 1024, 128}; pg8::BranchOrder S{opq(G), opq(bx)};
          pg8::EpiBranch E{(pg8::bf16_t*)(ws + WS_P)};
          pg8::gemm_phase<pg8::EpiBranch, pg8::BranchOrder, true, true>(lds + RING_OFF, g, S, E, opq(wave)); }
#endif
        xcd_barrier(bar, LEADER());
#ifndef NO_G3
        _Pragma("unroll 1") for (int rep = 0; rep < REP_GEMM; ++rep)
        { unsigned char* ws = opq_ptr(A.ws); const pg8::bf16_t* XB = (const pg8::bf16_t*)(ws + WS_XB);
          pg8::Gemm g{XB, (const pg8::bf16_t*)(ws + WS_WGATE) + (size_t)l * 3072 * 1024, M, 3072, D}; pg8::GateOrder S; S.so.init(M, 1024, opq(G), opq(bx));
          pg8::EpiMerge E{(const pg8::bf16_t*)(ws + WS_P), (pg8::bf16_t*)(ws + WS_QKV), M};
          pg8::gemm_phase<pg8::EpiMerge, pg8::GateOrder, true, true>(lds + RING_OFF, g, S, E, opq(wave)); }
#endif
        xcd_barrier(bar, LEADER());
#ifndef NO_G4
        _Pragma("unroll 1") for (int rep = 0; rep < REP_GEMM; ++rep)
        { unsigned char* ws = opq_ptr(A.ws); const float* xin = (l == 0) ? A.in[0] : (const float*)(ws + WS_X);
          pg8::Gemm g{(const pg8::bf16_t*)(ws + WS_QKV), (const pg8::bf16_t*)(ws + WS_WOUT) + (size_t)l * 1024 * 1024, M, 1024, D}; pg8::StaticOrder S; S.init(M, 1024, opq(G), opq(bx));
          pg8::EpiResF32 E{xin, (float*)(ws + WS_Y), D, ALPHA};
          pg8::gemm_phase<pg8::EpiResF32, pg8::StaticOrder, true, true>(lds + RING_OFF, g, S, E, opq(wave)); }
#endif
        xcd_barrier(bar, LEADER());
#ifndef NO_LN1
        ln1_phase(A, l, opq(vcu), NGW, opq(wave));
#endif
        xcd_barrier(bar, LEADER());
#ifndef NO_G5
        _Pragma("unroll 1") for (int rep = 0; rep < REP_GEMM; ++rep)
        { unsigned char* ws = opq_ptr(A.ws); const pg8::bf16_t* XB = (const pg8::bf16_t*)(ws + WS_XB);
          pg8::Gemm g{XB, (const pg8::bf16_t*)(ws + WS_WQ) + (size_t)l * 1024 * 1024, M, 1024, D}; pg8::StaticOrder S; S.init(M, 1024, opq(G), opq(bx));
          pg8::EpiBf16<0> E{(pg8::bf16_t*)(ws + WS_QP), 1024, nullptr, 0, 0, 1.f};
          pg8::gemm_phase<pg8::EpiBf16<0>, pg8::StaticOrder, true, true>(lds + RING_OFF, g, S, E, opq(wave)); }
#endif
        xcd_barrier(bar, LEADER());
#ifndef NO_PEER
        _Pragma("unroll 1") for (int rep = 0; rep < REP_PEER; ++rep)
        if (opq(G) == 256) peer_wave(A, l, opq(vcu), l == DEPTH - 1, opq(wave));
#endif
        if (l != DEPTH - 1) xcd_barrier(bar, LEADER());
    }
}

extern "C" void kernel_launch(void* const* d_in, const int* in_sizes, int n_in, void* d_out, int out_size, void* d_ws, size_t ws_size, hipStream_t stream) {
    static int grid = 0;
    if (grid == 0) {
        if (n_in != 19 || out_size != M * D || ws_size < WS_END2) { fprintf(stderr, "kernel_launch: unexpected shapes (n_in %d, out %d, ws %zu); nothing launched\n", n_in, out_size, ws_size); grid = -1; return; }
        int dev = 0, cus = 0, per_cu = 0;
        if (hipGetDevice(&dev) != hipSuccess || hipDeviceGetAttribute(&cus, hipDeviceAttributeMultiprocessorCount, dev) != hipSuccess) { grid = -1; return; }
        if (hipFuncSetAttribute((const void*)hybrid_fwd, hipFuncAttributeMaxDynamicSharedMemorySize, LDS_BYTES) != hipSuccess) { fprintf(stderr, "kernel_launch: hipFuncSetAttribute failed\n"); grid = -1; return; }
        if (hipOccupancyMaxActiveBlocksPerMultiprocessor(&per_cu, (const void*)hybrid_fwd, NWAVES * 64, LDS_BYTES) != hipSuccess || per_cu < 1)
            fprintf(stderr, "kernel_launch: note: occupancy query reports %d workgroups per CU\n", per_cu);
        (void)hipGetLastError();
        grid = cus;
    }
    if (grid < 0) return;
    if (hipMemsetAsync((char*)d_ws + WS_CTL, 0, CTL_ZERO_BYTES, stream) != hipSuccess) return;
    Ptrs a{};
    for (int i = 0; i < 19; ++i) a.in[i] = (const float*)d_in[i];
    a.out = (float*)d_out; a.ws = (unsigned char*)d_ws;
    hipLaunchKernelGGL(hybrid_fwd, dim3(grid), dim3(NWAVES * 64), LDS_BYTES, stream, a);
}
```
